# Optimizing an MI355X kernel written in HIP

```python
import math
import jax, jax.numpy as jnp
from jax import lax
import numpy as np

D_MODEL = 1024
BATCH = 8
SEQ = 2048
DEPTH = 2
DEC_BATCH = 128
DEC_SEQ = 4
PAST_LEN = 16384
PAGE_SIZE = 128

N_MIXERS = 2
N_A = (DEPTH + 1) // 2
N_B = DEPTH // 2
W_LRU = 1536
N_BLK = 16
BLK_W = W_LRU // N_BLK
CONV_W = 4
LRU_C = 8.0
EXPAND = 128
H_B = D_MODEL // EXPAND
DK_B = EXPAND
DV_B = D_MODEL // H_B
INNER_B = H_B * DK_B
CHUNK = 64
EPS = 1e-6

kernel_name = "hawk_hgrn2_hybrid_step"


def _rmsnorm(x, gain):
    xf = x.astype(jnp.float32)
    y = xf * lax.rsqrt(jnp.mean(xf * xf, axis=-1, keepdims=True) + EPS)
    return (y * gain.astype(jnp.float32)).astype(x.dtype)


def _causal_conv(xb, w, b, buf):
    T = xb.shape[1]
    xp = jnp.concatenate([buf.astype(xb.dtype), xb], axis=1)
    out = b
    for k in range(CONV_W):
        out = out + w[k] * xp[:, k:k + T]
    return out, xp[:, -(CONV_W - 1):]


def _lru_combine(e1, e2):
    a1, b1 = e1
    a2, b2 = e2
    return a1 * a2, a2 * b1 + b2


def _rg_lru(xc, w_r, b_r, w_i, b_i, lam, h0):
    Bsz, T, W = xc.shape
    xf = xc.astype(jnp.float32)
    xh = xf.reshape(Bsz, T, N_BLK, BLK_W)
    r = jax.nn.sigmoid(jnp.einsum('btni,nij->btnj', xh, w_r.astype(jnp.float32)).reshape(Bsz, T, W) + b_r)
    ig = jax.nn.sigmoid(jnp.einsum('btni,nij->btnj', xh, w_i.astype(jnp.float32)).reshape(Bsz, T, W) + b_i)
    log_a = -LRU_C * jax.nn.softplus(-lam.astype(jnp.float32)) * r
    a = jnp.exp(log_a)
    bterm = jnp.sqrt(-jnp.expm1(2.0 * log_a)) * (ig * xf)
    bterm = bterm.at[:, 0].add(a[:, 0] * h0.astype(jnp.float32))
    _, h = lax.associative_scan(_lru_combine, (a, bterm), axis=1)
    return h, h[:, -1]


def _lru_layer(x, g_norm, w_in, conv_w, conv_b, w_r, b_r, w_i, b_i, lam, w_out, h0, buf):
    xn = _rmsnorm(x, g_norm)
    u = xn @ w_in
    xb, gate = u[..., :W_LRU], u[..., W_LRU:]
    xc, new_buf = _causal_conv(xb, conv_w, conv_b, buf)
    h, h_last = _rg_lru(xc, w_r, b_r, w_i, b_i, lam, h0)
    y = (h * jax.nn.silu(gate.astype(jnp.float32))).astype(x.dtype)
    return x + y @ w_out, h_last.astype(x.dtype), new_buf.astype(x.dtype)


def _hgrn2_chunked(q, k, v, log_g, S0):
    Bsz, T, H, DK = q.shape
    DV = v.shape[-1]
    C = math.gcd(T, CHUNK)
    n = T // C

    def to_chunks(z):
        return z.reshape(Bsz, n, C, H, z.shape[-1]).transpose(1, 0, 3, 2, 4)

    qs, ks, vs, gs = to_chunks(q), to_chunks(k), to_chunks(v), to_chunks(log_g)
    causal = jnp.tril(jnp.ones((C, C), dtype=bool))

    def step(S, inp):
        qc, kc, vc, gc = inp
        cum = jnp.cumsum(gc, axis=2)
        inter = jnp.einsum('bhtk,bhkv->bhtv', qc * jnp.exp(cum), S)
        diff = cum[:, :, :, None, :] - cum[:, :, None, :, :]
        decay = jnp.exp(jnp.where(causal[:, :, None], diff, -jnp.inf))
        attn = jnp.einsum('bhtk,bhsk,bhtsk->bhts', qc, kc, decay)
        intra = jnp.einsum('bhts,bhsv->bhtv', attn, vc)
        last = cum[:, :, -1:, :]
        S_new = jnp.exp(last[:, :, 0, :])[..., None] * S + jnp.einsum(
            'bhsk,bhsv->bhkv', kc * jnp.exp(last - cum), vc)
        return S_new, inter + intra

    S_T, o = lax.scan(step, S0.astype(jnp.float32), (qs, ks, vs, gs))
    o = o.transpose(1, 0, 3, 2, 4).reshape(Bsz, T, H, DV)
    return o, S_T


def _hgrn_layer(x, g_norm, w_in, lb, o_gain, w_out, S0):
    Bsz, T, _ = x.shape
    xn = _rmsnorm(x, g_norm)
    u = (xn @ w_in).astype(jnp.float32)
    q, f, iv, gate = jnp.split(u, 4, axis=-1)
    q = jax.nn.silu(q).reshape(Bsz, T, H_B, DK_B)
    lbh = lb.reshape(H_B, DK_B)
    log_g = jnp.logaddexp(jnp.log(lbh), jnp.log1p(-lbh) + jax.nn.log_sigmoid(f.reshape(Bsz, T, H_B, DK_B)))
    k = -jnp.expm1(log_g)
    v = iv.reshape(Bsz, T, H_B, DV_B)
    o, S_T = _hgrn2_chunked(q, k, v, log_g, S0)
    o = o * lax.rsqrt(jnp.mean(o * o, axis=-1, keepdims=True) + EPS) * o_gain.reshape(H_B, DV_B).astype(jnp.float32)
    y = (o.reshape(Bsz, T, INNER_B) * jax.nn.silu(gate)).astype(x.dtype)
    return x + y @ w_out, S_T.astype(x.dtype)


def _trunk(x, h0s, buf0s, S0s, norm_gain, a_w_in, a_conv_w, a_conv_b, a_w_r, a_b_r, a_w_i, a_b_i,
           a_lambda, a_w_out, b_w_in, b_lb_logits, b_o_gain, b_w_out, final_gain):
    sm = jax.nn.softmax(b_lb_logits.astype(jnp.float32), axis=0)
    lb_all = jnp.cumsum(sm, axis=0) - sm[0]
    hs, bufs, Ss = [], [], []
    for i in range(DEPTH):
        j = i // N_MIXERS
        if i % N_MIXERS == 0:
            x, h, bf = _lru_layer(x, norm_gain[i], a_w_in[j], a_conv_w[j], a_conv_b[j], a_w_r[j], a_b_r[j],
                                  a_w_i[j], a_b_i[j], a_lambda[j], a_w_out[j], h0s[j], buf0s[j])
            hs.append(h)
            bufs.append(bf)
        else:
            x, S = _hgrn_layer(x, norm_gain[i], b_w_in[j], lb_all[i], b_o_gain[j], b_w_out[j], S0s[j])
            Ss.append(S)
    return _rmsnorm(x, final_gain), jnp.stack(hs), jnp.stack(bufs), jnp.stack(Ss)


def setup_inputs(seed: int = 0) -> dict:
    key = jax.random.key(seed)
    ks = jax.random.split(key, 24)
    nrm = jax.random.normal
    f32 = jnp.float32
    a_sig = jax.random.uniform(ks[12], (N_A, W_LRU), f32, 0.9, 0.999)
    return {
        "x_prompt": nrm(ks[0], (BATCH, SEQ, D_MODEL), f32),
        "x_sample": nrm(ks[1], (DEC_BATCH, DEC_SEQ, D_MODEL), f32),
        "state_lru_h": 0.5 * nrm(ks[2], (N_A, DEC_BATCH, W_LRU), f32),
        "state_lru_conv": nrm(ks[3], (N_A, DEC_BATCH, CONV_W - 1, W_LRU), f32),
        "state_hgrn": 0.5 * nrm(ks[4], (N_B, DEC_BATCH, H_B, DK_B, DV_B), f32),
        "norm_gain": 1.0 + 0.1 * nrm(ks[5], (DEPTH, D_MODEL), f32),
        "a_w_in": nrm(ks[6], (N_A, D_MODEL, 2 * W_LRU), f32) * D_MODEL ** -0.5,
        "a_conv_w": nrm(ks[7], (N_A, CONV_W, W_LRU), f32) * CONV_W ** -0.5,
        "a_conv_b": 0.01 * nrm(ks[8], (N_A, W_LRU), f32),
        "a_w_r": nrm(ks[9], (N_A, N_BLK, BLK_W, BLK_W), f32) * BLK_W ** -0.5,
        "a_b_r": 0.01 * nrm(ks[10], (N_A, W_LRU), f32),
        "a_w_i": nrm(ks[11], (N_A, N_BLK, BLK_W, BLK_W), f32) * BLK_W ** -0.5,
        "a_b_i": 0.01 * nrm(ks[13], (N_A, W_LRU), f32),
        "a_lambda": jnp.log(a_sig) - jnp.log1p(-a_sig),
        "a_w_out": nrm(ks[14], (N_A, W_LRU, D_MODEL), f32) * W_LRU ** -0.5,
        "b_w_in": nrm(ks[15], (N_B, D_MODEL, 4 * INNER_B), f32) * D_MODEL ** -0.5,
        "b_lb_logits": nrm(ks[16], (DEPTH, INNER_B), f32),
        "b_o_gain": 1.0 + 0.1 * nrm(ks[17], (N_B, INNER_B), f32),
        "b_w_out": nrm(ks[18], (N_B, INNER_B, D_MODEL), f32) * INNER_B ** -0.5,
        "final_gain": 1.0 + 0.1 * nrm(ks[19], (D_MODEL,), f32),
    }


def reference(x_prompt, x_sample, state_lru_h, state_lru_conv, state_hgrn, norm_gain, a_w_in, a_conv_w,
              a_conv_b, a_w_r, a_b_r, a_w_i, a_b_i, a_lambda, a_w_out, b_w_in, b_lb_logits, b_o_gain,
              b_w_out, final_gain):
    dt = x_prompt.dtype
    h0p = jnp.zeros((N_A, BATCH, W_LRU), dt)
    buf0p = jnp.zeros((N_A, BATCH, CONV_W - 1, W_LRU), dt)
    S0p = jnp.zeros((N_B, BATCH, H_B, DK_B, DV_B), dt)
    y_prompt, hp, bp, Sp = _trunk(x_prompt, h0p, buf0p, S0p, norm_gain, a_w_in, a_conv_w, a_conv_b, a_w_r,
                                  a_b_r, a_w_i, a_b_i, a_lambda, a_w_out, b_w_in, b_lb_logits, b_o_gain,
                                  b_w_out, final_gain)
    y_sample, hs, bs, Ss = _trunk(x_sample, state_lru_h, state_lru_conv, state_hgrn, norm_gain, a_w_in,
                                  a_conv_w, a_conv_b, a_w_r, a_b_r, a_w_i, a_b_i, a_lambda, a_w_out, b_w_in,
                                  b_lb_logits, b_o_gain, b_w_out, final_gain)
    return (y_prompt, y_sample, hp, bp, Sp, hs, bs, Ss)
```

```cpp
#include <hip/hip_runtime.h>
#include <hip/hip_cooperative_groups.h>
#include <cstdio>
#include <cstdint>
namespace cg = cooperative_groups;
namespace pg8 {
#define PG8_LAS __attribute__((address_space(3)))
typedef unsigned short bf16_t;
typedef short bf16x8 __attribute__((ext_vector_type(8)));
typedef float f32x4 __attribute__((ext_vector_type(4)));
typedef unsigned u32x4 __attribute__((ext_vector_type(4)));
constexpr int BM = 256, BK = 64, HALF = 128, HTB = HALF * BK * 2  , STAGE_BYTES = 8 * HTB, NXCD = 8, WGM = 8;

__host__ __device__ __forceinline__ int lds_byte(int r, int c) { const int st = (r >> 4) * 2 + (c >> 5), rr = r & 15, cc = c & 31, ob = rr * 64 + cc * 2; return st * 1024 + (ob ^ (((ob >> 9) & 1) << 5)); }
__host__ __device__ __forceinline__ void stage_rc(int b, int& R, int& C) { const int st = b / 1024, sb = b % 1024, swz = sb ^ (((sb >> 9) & 1) << 5); R = (st >> 1) * 16 + swz / 64; C = (st & 1) * 32 + (swz % 64) / 2; }
__host__ __device__ __forceinline__ int perm32(int rho) { const int n = rho >> 4, i = rho & 15; return 8 * (i >> 2) + 4 * n + (i & 3); }

struct Unit { int pm, pn; };
struct Gemm { const bf16_t* A; const bf16_t* Bt; int M, N, K; };

struct StaticOrder {
    int nM, nN, nwg, G, c;
    __host__ __device__ void init(int M, int N, int G_, int c_) { nM = M / BM; nN = N / BM; nwg = nM * nN; G = G_; c = c_; }
    __host__ __device__ bool next(int i, Unit& u) const {
        const long L = (long)i * G + c; if (L >= nwg) return false;
        int wgid = (int)L; { const int q = nwg / NXCD, r = nwg % NXCD, xcd = wgid % NXCD, off = wgid / NXCD; wgid = (xcd < r ? xcd * (q + 1) : r * (q + 1) + (xcd - r) * q) + off; }
        const int nig = WGM * nN, gid = wgid / nig, fm = gid * WGM, gsz = (nM - fm) < WGM ? (nM - fm) : WGM;
        u.pm = fm + ((wgid % nig) % gsz); u.pn = (wgid % nig) / gsz; return true;
    }
    __device__ __forceinline__ void a_ready(const Unit&) const {}
    __device__ __forceinline__ void done(const Unit&) const {}
};

typedef float f32x2c __attribute__((ext_vector_type(2)));
typedef __bf16 bf16x2c __attribute__((ext_vector_type(2)));
__device__ __forceinline__ unsigned cvt_pk_bf16(float lo, float hi) { const f32x2c v = {lo, hi}; return __builtin_bit_cast(unsigned, __builtin_convertvector(v, bf16x2c)); }
template <class Epi, class Sched, bool ALIGN_EPI = false, bool SP2 = false>
__device__ __forceinline__ void gemm_phase(PG8_LAS unsigned char* lds, const Gemm g, const Sched& S, const Epi& E) {
    const int tid = threadIdx.x, wid = __builtin_amdgcn_readfirstlane(tid >> 6), lane = tid & 63, wr = wid >> 2, wc = wid & 3, fr = lane & 15, fq = lane >> 4;
    const int K = g.K, nt = K / BK;
    unsigned voffA[2], voffB[2];
#pragma unroll
    for (int i = 0; i < 2; ++i) { int R, C; stage_rc(tid * 16 + i * 8192, R, C); const int Rb = Epi::PERM ? ((R & ~31) + perm32(R & 31)) : R;
        voffA[i] = (unsigned)(R * K + C) * 2u; voffB[i] = (unsigned)(Rb * K + C) * 2u; }
    const size_t kstep = (size_t)(BK * 2);
    const size_t hstep = (size_t)HALF * K * 2;
    const size_t tstep = 2 * hstep;
    const unsigned ldsw = (unsigned)wid * 1024u;
    const int aoff = lds_byte(wr * 64 + fr, fq * 8), boff = lds_byte(wc * 32 + fr, fq * 8);
#define PG8_SA(b, h) (((b) * 2 + (h)) * HTB)
#define PG8_SB(b, h) ((4 + (b) * 2 + (h)) * HTB)
#define PG8_STAGE(bufoff, gbase, voff) do { _Pragma("unroll") for (int _i = 0; _i < 2; ++_i) \
        __builtin_amdgcn_global_load_lds((const unsigned*)((const char*)(gbase) + (voff)[_i]), (PG8_LAS unsigned*)(lds + (bufoff) + ldsw + _i * 8192), 16, 0, 0); } while (0)
#define PG8_LDA(dst, b, h) do { _Pragma("unroll") for (int m = 0; m < 4; ++m) _Pragma("unroll") for (int k = 0; k < 2; ++k) dst[m][k] = *(const PG8_LAS bf16x8*)(lds + PG8_SA(b, h) + aoff + m * 2048 + k * 1024); } while (0)
#define PG8_LDB(dst, b, h) do { _Pragma("unroll") for (int n = 0; n < 2; ++n) _Pragma("unroll") for (int k = 0; k < 2; ++k) dst[n][k] = *(const PG8_LAS bf16x8*)(lds + PG8_SB(b, h) + boff + n * 2048 + k * 1024); } while (0)
#define PG8_MMA(ai, bj, At, Bt) do { __builtin_amdgcn_s_setprio(1); _Pragma("unroll") for (int m = 0; m < 4; ++m) _Pragma("unroll") for (int n = 0; n < 2; ++n) _Pragma("unroll") for (int k = 0; k < 2; ++k) \
        acc[ai][bj][m][n] = __builtin_amdgcn_mfma_f32_16x16x32_bf16(Bt[n][k], At[m][k], acc[ai][bj][m][n], 0, 0, 0); __builtin_amdgcn_s_setprio(0); } while (0)
#define PG8_WAIT_V(n) asm volatile("s_waitcnt vmcnt(" #n ")" ::: "memory")
#define PG8_WAIT_L(n) asm volatile("s_waitcnt lgkmcnt(" #n ")" ::: "memory")
#define PG8_BAR __builtin_amdgcn_s_barrier()
#define PG8_SCHED __builtin_amdgcn_sched_barrier(0)
    Unit cur, nxt; int ui = 0;
    if (!S.next(0, cur)) return;
    f32x4 acc[2][2][4][2];
#pragma unroll
    for (int a = 0; a < 2; ++a)
#pragma unroll
        for (int b = 0; b < 2; ++b)
#pragma unroll
            for (int m = 0; m < 4; ++m)
#pragma unroll
                for (int n = 0; n < 2; ++n) acc[a][b][m][n] = (f32x4){0.f, 0.f, 0.f, 0.f};
    bf16x8 At[4][2], B0[2][2], B1[2][2];
    const char* cA = (const char*)g.A + (size_t)cur.pm * tstep; const char* cB = (const char*)g.Bt + (size_t)cur.pn * tstep;
    S.a_ready(cur);
    if constexpr (SP2) {
        PG8_STAGE(PG8_SB(0, 0), cB, voffB); PG8_STAGE(PG8_SB(0, 1), cB + hstep, voffB); PG8_STAGE(PG8_SA(0, 0), cA, voffA); PG8_STAGE(PG8_SA(0, 1), cA + hstep, voffA);
        if (wr == 1) PG8_BAR;
        PG8_WAIT_V(2); PG8_BAR;
        PG8_STAGE(PG8_SB(1, 0), cB + kstep, voffB); PG8_STAGE(PG8_SA(1, 0), cA + kstep, voffA); PG8_STAGE(PG8_SB(1, 1), cB + hstep + kstep, voffB);
        PG8_WAIT_V(6); PG8_BAR;
    } else {
        PG8_STAGE(PG8_SB(0, 0), cB, voffB); PG8_STAGE(PG8_SA(0, 0), cA, voffA); PG8_STAGE(PG8_SB(0, 1), cB + hstep, voffB); PG8_STAGE(PG8_SA(0, 1), cA + hstep, voffA);
        if (wr == 1) PG8_BAR;
        PG8_WAIT_V(4); PG8_BAR;
        PG8_STAGE(PG8_SB(1, 0), cB + kstep, voffB); PG8_STAGE(PG8_SA(1, 0), cA + kstep, voffA); PG8_STAGE(PG8_SB(1, 1), cB + hstep + kstep, voffB);
        PG8_WAIT_V(6); PG8_BAR;
    }
    for (;;) {
        const bool has_next = S.next(ui + 1, nxt);
        const char* nA = has_next ? (const char*)g.A + (size_t)nxt.pm * tstep : cA; const char* nB = has_next ? (const char*)g.Bt + (size_t)nxt.pn * tstep : cB;
        for (int t = 0; t < nt; t += 2) {
            const bool last = (t == nt - 2);
            const char* a1 = cA + (size_t)(t + 1) * kstep;
            const char* a2 = last ? nA : cA + (size_t)(t + 2) * kstep; const char* b2 = last ? nB : cB + (size_t)(t + 2) * kstep;
            const char* a3 = a2 + kstep; const char* b3 = b2 + kstep;
            if (last && has_next) S.a_ready(nxt);
            if constexpr (SP2) {
            PG8_LDB(B0, 0, 0); PG8_LDB(B1, 0, 1); PG8_SCHED; PG8_LDA(At, 0, 0); PG8_STAGE(PG8_SA(1, 1), a1 + hstep, voffA);
            PG8_WAIT_V(8); PG8_WAIT_L(0); PG8_BAR; PG8_MMA(0, 0, At, B0); PG8_MMA(0, 1, At, B1); PG8_BAR; PG8_SCHED;
            PG8_LDA(At, 0, 1); PG8_STAGE(PG8_SB(0, 0), b2, voffB); PG8_STAGE(PG8_SB(0, 1), b2 + hstep, voffB); PG8_STAGE(PG8_SA(0, 0), a2, voffA);
            PG8_WAIT_V(8); PG8_WAIT_L(0); PG8_BAR; PG8_MMA(1, 0, At, B0); PG8_MMA(1, 1, At, B1); PG8_BAR; PG8_SCHED;
            PG8_LDB(B0, 1, 0); PG8_LDB(B1, 1, 1); PG8_SCHED; PG8_LDA(At, 1, 0); PG8_STAGE(PG8_SA(0, 1), a2 + hstep, voffA);
            PG8_WAIT_V(8); PG8_WAIT_L(0); PG8_BAR; PG8_MMA(0, 0, At, B0); PG8_MMA(0, 1, At, B1); PG8_BAR; PG8_SCHED;
            PG8_LDA(At, 1, 1); PG8_STAGE(PG8_SB(1, 0), b3, voffB); PG8_STAGE(PG8_SB(1, 1), b3 + hstep, voffB); PG8_STAGE(PG8_SA(1, 0), a3, voffA);
            PG8_WAIT_V(8); PG8_WAIT_L(0); PG8_BAR; PG8_MMA(1, 0, At, B0); PG8_MMA(1, 1, At, B1); PG8_BAR; PG8_SCHED;
            } else {
            PG8_LDB(B0, 0, 0); PG8_SCHED; PG8_LDA(At, 0, 0); PG8_STAGE(PG8_SA(1, 1), a1 + hstep, voffA);
            PG8_WAIT_L(8); PG8_BAR; PG8_WAIT_L(0); PG8_MMA(0, 0, At, B0); PG8_BAR; PG8_SCHED;
            PG8_LDB(B1, 0, 1); PG8_STAGE(PG8_SB(0, 0), b2, voffB);
            PG8_BAR; PG8_WAIT_L(0); PG8_MMA(0, 1, At, B1); PG8_BAR;
            PG8_LDA(At, 0, 1); PG8_STAGE(PG8_SA(0, 0), a2, voffA);
            PG8_BAR; PG8_WAIT_L(0); PG8_MMA(1, 0, At, B0); PG8_BAR; PG8_SCHED;
            PG8_STAGE(PG8_SB(0, 1), b2 + hstep, voffB);
            PG8_WAIT_V(6); PG8_BAR; PG8_MMA(1, 1, At, B1); PG8_BAR;
            PG8_LDB(B0, 1, 0); PG8_SCHED; PG8_LDA(At, 1, 0); PG8_STAGE(PG8_SA(0, 1), a2 + hstep, voffA);
            PG8_WAIT_L(8); PG8_BAR; PG8_WAIT_L(0); PG8_MMA(0, 0, At, B0); PG8_BAR; PG8_SCHED;
            PG8_LDB(B1, 1, 1); PG8_STAGE(PG8_SB(1, 0), b3, voffB);
            PG8_BAR; PG8_WAIT_L(0); PG8_MMA(0, 1, At, B1); PG8_BAR;
            PG8_LDA(At, 1, 1); PG8_STAGE(PG8_SA(1, 0), a3, voffA);
            PG8_BAR; PG8_WAIT_L(0); PG8_MMA(1, 0, At, B0); PG8_BAR; PG8_SCHED;
            PG8_STAGE(PG8_SB(1, 1), b3 + hstep, voffB);
            PG8_WAIT_V(6); PG8_BAR; PG8_MMA(1, 1, At, B1); PG8_BAR;
            }
        }
        if constexpr (ALIGN_EPI) { if (wr == 0) PG8_BAR; }
        if constexpr (!Epi::AFTER_DRAIN) { E(acc, cur, wr, wc, fr, fq); S.done(cur); }
        if (!has_next) break;
#pragma unroll
        for (int a = 0; a < 2; ++a)
#pragma unroll
            for (int b = 0; b < 2; ++b)
#pragma unroll
                for (int m = 0; m < 4; ++m)
#pragma unroll
                    for (int n = 0; n < 2; ++n) acc[a][b][m][n] = (f32x4){0.f, 0.f, 0.f, 0.f};
        cur = nxt; cA = nA; cB = nB; ++ui;
        if constexpr (ALIGN_EPI) { if (wr == 1) PG8_BAR; }
    }
    PG8_WAIT_V(0);
    if constexpr (!ALIGN_EPI) { if (wr == 0) PG8_BAR; }
    PG8_BAR;
    if constexpr (Epi::AFTER_DRAIN) { E.fused(acc, cur, wr, wc, fr, fq, lds, wid, lane); S.done(cur); }
#undef PG8_SA
#undef PG8_SB
#undef PG8_STAGE
#undef PG8_LDA
#undef PG8_LDB
#undef PG8_MMA
#undef PG8_WAIT_V
#undef PG8_WAIT_L
#undef PG8_BAR
#undef PG8_SCHED
}
}
using pg8::bf16_t; using pg8::bf16x8; using pg8::f32x4; using pg8::u32x4; using pg8::Unit; using pg8::cvt_pk_bf16;
#define LAS __attribute__((address_space(3)))
typedef float f32x16 __attribute__((ext_vector_type(16)));
typedef unsigned u32x2 __attribute__((ext_vector_type(2)));
typedef short s16x4 __attribute__((ext_vector_type(4)));

#ifndef MK_USE_CG
#define MK_USE_CG 0
#endif
#ifndef MK_DUP
#define MK_DUP -1
#endif
#ifndef MK_LAUNCHES
#define MK_LAUNCHES 1
#endif
constexpr int NPHASE = 9;
constexpr int NTHREADS = 512, NWAVES = 8;
constexpr int LDS_BYTES = 147456;
constexpr int D = 1024, TP = 2048, NBP = 8, MP = NBP * TP  , NSQ = 128, TS = 4, MS = NSQ * TS  , M = MP + MS  ;
constexpr int WL = 1536, NBLK = 16, BW = 96;
constexpr int NH = 8, DK = 128, INNER = 1024;
constexpr float EPS = 1e-6f;
constexpr float LOG2E = 1.4426950408889634f;
constexpr size_t O_Y = 0, O_HP = 17301504, O_BP = 17313792, O_SP = 17350656, O_HS = 18399232, O_BS = 18595840, O_SS = 19185664;
constexpr size_t MiB = 1u << 20;
constexpr size_t WS_SS1 = 1 * MiB, WS_SS2 = WS_SS1 + 128 * 1024;
constexpr size_t WS_W1T = 2 * MiB, WS_W2T = 8 * MiB, WS_W3T = 11 * MiB, WS_W4T = 19 * MiB, WS_WRT = 21 * MiB, WS_LGS = 22 * MiB;
constexpr size_t WS_XA = 24 * MiB;
constexpr size_t WS_XB = 58 * MiB;
constexpr size_t WS_GS = WS_XB + (size_t)M * WL * 2;
constexpr size_t WS_Y = WS_GS + (size_t)M * WL * 2;
constexpr size_t WS_QB = 58 * MiB;
constexpr size_t WS_VB = 91 * MiB;
constexpr size_t WS_GB = 124 * MiB;
constexpr size_t WS_OPI = 157 * MiB;
constexpr size_t OPI_BYTES = 24576;
constexpr size_t WS_DV = 253 * MiB;
constexpr size_t WS_END = 256 * MiB;
static_assert(WS_OPI + 4096 * OPI_BYTES <= WS_DV, "ws map (operand images)");
static_assert(WS_GB - WS_VB == WS_VB - WS_QB && WS_Y + (size_t)M * WL * 2 <= 256 * MiB && WS_XA + (size_t)M * D * 2 <= WS_XB, "ws map");

struct Args { const float* in[20]; float* out; unsigned char* ws; int ph_lo, ph_hi; };

__device__ __forceinline__ float bf2f(unsigned short b) { return __builtin_bit_cast(float, (unsigned)b << 16); }
__device__ __forceinline__ float bflo(unsigned u) { return __builtin_bit_cast(float, u << 16); }
__device__ __forceinline__ float bfhi(unsigned u) { return __builtin_bit_cast(float, u & 0xffff0000u); }
typedef float f32x2_ __attribute__((ext_vector_type(2)));
typedef __bf16 bf16x2_ __attribute__((ext_vector_type(2)));
__device__ __forceinline__ unsigned pk2(float lo, float hi) { const f32x2_ v = {lo, hi}; return __builtin_bit_cast(unsigned, __builtin_convertvector(v, bf16x2_)); }
__device__ __forceinline__ unsigned f2bf(float f) { return pk2(f, f) & 0xffffu; }
__device__ __forceinline__ float ex2(float x) { return __builtin_amdgcn_exp2f(x); }
__device__ __forceinline__ float rcpf_(float x) { return __builtin_amdgcn_rcpf(x); }
__device__ __forceinline__ float sigmoidf_(float x) { return rcpf_(1.0f + ex2(-LOG2E * x)); }
__device__ __forceinline__ float siluf_(float x) { return x * sigmoidf_(x); }
__device__ __forceinline__ float wave_sum(float v) {
#pragma unroll
    for (int o = 1; o < 64; o <<= 1) v += __shfl_xor(v, o);
    return v;
}
#define LDS_WAIT() asm volatile("s_waitcnt lgkmcnt(0)" ::: "memory")
#define VM_WAIT() asm volatile("s_waitcnt vmcnt(0)" ::: "memory")

struct Epi1 {
    static constexpr bool PERM = true, AFTER_DRAIN = false;
    bf16_t* XB; bf16_t* GS; float* obp; float* obs;
    __device__ __forceinline__ void operator()(const f32x4 (&acc)[2][2][4][2], const Unit& u, int wr, int wc, int fr, int fq) const {
        const int row0 = u.pm * 256 + wr * 64 + fr; const bool isg = u.pn >= 6;
        const int colt = (isg ? u.pn - 6 : u.pn) * 256 + wc * 32 + 8 * fq; bf16_t* base = isg ? GS : XB;
#pragma unroll
        for (int ai = 0; ai < 2; ++ai)
#pragma unroll
            for (int m = 0; m < 4; ++m) { const int row = row0 + ai * 128 + m * 16;
                float* cb = nullptr;
                if (!isg) { if (row < MP) { const int t = row & (TP - 1); if (t >= TP - 3) cb = obp + ((size_t)((row >> 11) * 3 + (t - (TP - 3))) * WL); }
                            else { const int rs = row - MP, t = rs & 3; if (t >= 1) cb = obs + ((size_t)((rs >> 2) * 3 + (t - 1)) * WL); } }
#pragma unroll
                for (int bj = 0; bj < 2; ++bj) { f32x4 v0 = acc[ai][bj][m][0], v1 = acc[ai][bj][m][1]; const int col = colt + bj * 128;
                    if (isg) {
#pragma unroll
                        for (int j = 0; j < 4; ++j) { v0[j] = siluf_(v0[j]); v1[j] = siluf_(v1[j]); } }
                    else if (cb) { *(f32x4*)(cb + col) = v0; *(f32x4*)(cb + col + 4) = v1; }
                    u32x4 w; w.x = cvt_pk_bf16(v0[0], v0[1]); w.y = cvt_pk_bf16(v0[2], v0[3]); w.z = cvt_pk_bf16(v1[0], v1[1]); w.w = cvt_pk_bf16(v1[2], v1[3]);
                    *(u32x4*)(base + (size_t)row * WL + col) = w; } }
    }
};
struct Epi2 {
    static constexpr bool PERM = true, AFTER_DRAIN = false;
    const float* xp; const float* xs; float* X1; bf16_t* X1B; float* ss;
    __device__ __forceinline__ void operator()(const f32x4 (&acc)[2][2][4][2], const Unit& u, int wr, int wc, int fr, int fq) const {
        const int row0 = u.pm * 256 + wr * 64 + fr, colt = u.pn * 256 + wc * 32 + 8 * fq;
#pragma unroll
        for (int ai = 0; ai < 2; ++ai)
#pragma unroll
            for (int m = 0; m < 4; ++m) { const int row = row0 + ai * 128 + m * 16;
                const float* xin = row < MP ? xp + (size_t)row * D : xs + (size_t)(row - MP) * D; float sq = 0.f;
#pragma unroll
                for (int bj = 0; bj < 2; ++bj) { const int col = colt + bj * 128;
                    f32x4 v0 = acc[ai][bj][m][0] + *(const f32x4*)(xin + col), v1 = acc[ai][bj][m][1] + *(const f32x4*)(xin + col + 4);
                    sq += (v0[0] * v0[0] + v0[1] * v0[1]) + (v0[2] * v0[2] + v0[3] * v0[3]) + (v1[0] * v1[0] + v1[1] * v1[1]) + (v1[2] * v1[2] + v1[3] * v1[3]);
                    u32x4 w; w.x = cvt_pk_bf16(v0[0], v0[1]); w.y = cvt_pk_bf16(v0[2], v0[3]); w.z = cvt_pk_bf16(v1[0], v1[1]); w.w = cvt_pk_bf16(v1[2], v1[3]);
                    *(u32x4*)(X1B + (size_t)row * D + col) = w; }
                sq += __shfl_xor(sq, 16); sq += __shfl_xor(sq, 32);
                if (fq == 0) atomicAdd(ss + row, sq); }
    }
};
__device__ __forceinline__ f32x4 lbvec(const float* l0) { const f32x4 a = *(const f32x4*)l0, c = *(const f32x4*)(l0 + D); return (f32x4){sigmoidf_(c[0] - a[0]), sigmoidf_(c[1] - a[1]), sigmoidf_(c[2] - a[2]), sigmoidf_(c[3] - a[3])}; }
struct Epi3 {
    static constexpr bool PERM = true, AFTER_DRAIN = false;
    const float* ss1; const float* lbl; bf16_t* QB; bf16_t* VB; bf16_t* GB; float* LGp; float* LGs;
    __device__ __forceinline__ void operator()(const f32x4 (&acc)[2][2][4][2], const Unit& u, int wr, int wc, int fr, int fq) const {
        const int row0 = u.pm * 256 + wr * 64 + fr, sec = u.pn >> 2, colt = (u.pn & 3) * 256 + wc * 32 + 8 * fq;
        const f32x4 lbA0 = lbvec(lbl + colt), lbA1 = lbvec(lbl + colt + 4), lbB0 = lbvec(lbl + colt + 128), lbB1 = lbvec(lbl + colt + 132);
        bf16_t* ob = QB + (size_t)(sec == 0 ? 0 : sec - 1) * ((WS_VB - WS_QB) / 2);
#pragma unroll
        for (int ai = 0; ai < 2; ++ai)
#pragma unroll
            for (int m = 0; m < 4; ++m) { const int row = row0 + ai * 128 + m * 16;
                const float rstd = __builtin_amdgcn_rsqf(ss1[row] * (1.0f / D) + EPS);
#pragma unroll
                for (int bj = 0; bj < 2; ++bj) { f32x4 v0 = acc[ai][bj][m][0] * rstd, v1 = acc[ai][bj][m][1] * rstd; const int col = colt + bj * 128;
                    if (sec == 1) { const f32x4 l0v = bj ? lbB0 : lbA0, l1v = bj ? lbB1 : lbA1;
#pragma unroll
                        for (int j = 0; j < 4; ++j) { v0[j] = __builtin_amdgcn_logf(l0v[j] + (1.0f - l0v[j]) * sigmoidf_(v0[j])); v1[j] = __builtin_amdgcn_logf(l1v[j] + (1.0f - l1v[j]) * sigmoidf_(v1[j])); }
                        float* lp = (row < MP ? LGp + (size_t)row * INNER : LGs + (size_t)(row - MP) * INNER) + col;
                        *(f32x4*)lp = v0; *(f32x4*)(lp + 4) = v1;
                    } else {
                        if (sec != 2) {
#pragma unroll
                            for (int j = 0; j < 4; ++j) { v0[j] = siluf_(v0[j]); v1[j] = siluf_(v1[j]); } }
                        u32x4 w; w.x = cvt_pk_bf16(v0[0], v0[1]); w.y = cvt_pk_bf16(v0[2], v0[3]); w.z = cvt_pk_bf16(v1[0], v1[1]); w.w = cvt_pk_bf16(v1[2], v1[3]);
                        *(u32x4*)(ob + (size_t)row * INNER + col) = w; } } }
    }
};
struct OneUnit { int pm, pn;
    __device__ __forceinline__ bool next(int i, Unit& u) const { if (i > 0) return false; u.pm = pm; u.pn = pn; return true; }
    __device__ __forceinline__ void a_ready(const Unit&) const {}
    __device__ __forceinline__ void done(const Unit&) const {} };
struct Epi4 {
    static constexpr bool PERM = true, AFTER_DRAIN = false;
    const bf16_t* X1B; float* ss; float* XO;
    __device__ __forceinline__ void operator()(const f32x4 (&acc)[2][2][4][2], const Unit& u, int wr, int wc, int fr, int fq) const {
        const int row0 = u.pm * 256 + wr * 64 + fr, colt = u.pn * 256 + wc * 32 + 8 * fq;
#pragma unroll
        for (int ai = 0; ai < 2; ++ai)
#pragma unroll
            for (int m = 0; m < 4; ++m) { const int row = row0 + ai * 128 + m * 16; float sq = 0.f;
#pragma unroll
                for (int bj = 0; bj < 2; ++bj) { const size_t e = (size_t)row * D + colt + bj * 128; const u32x4 xb = *(const u32x4*)(X1B + e);
                    f32x4 v0 = acc[ai][bj][m][0] + (f32x4){bflo(xb.x), bfhi(xb.x), bflo(xb.y), bfhi(xb.y)}, v1 = acc[ai][bj][m][1] + (f32x4){bflo(xb.z), bfhi(xb.z), bflo(xb.w), bfhi(xb.w)};
                    *(f32x4*)(XO + e) = v0; *(f32x4*)(XO + e + 4) = v1;
                    sq += (v0[0] * v0[0] + v0[1] * v0[1]) + (v0[2] * v0[2] + v0[3] * v0[3]) + (v1[0] * v1[0] + v1[1] * v1[1]) + (v1[2] * v1[2] + v1[3] * v1[3]); }
                sq += __shfl_xor(sq, 16); sq += __shfl_xor(sq, 32);
                if (fq == 0) atomicAdd(ss + row, sq); }
    }
};
template <int MODE>
__device__ __forceinline__ void small_gemm_sample(const bf16_t* A, const bf16_t* Bt, int K, const float* xs, float* X, const bf16_t* X1Bc, float* ss) { bf16_t* X1B = const_cast<bf16_t*>(X1Bc);
    const int tid = threadIdx.x, lane = tid & 63, wave = __builtin_amdgcn_readfirstlane(tid >> 6), fr = lane & 15, fq = lane >> 4;
    for (int tile = blockIdx.x; tile < 256; tile += gridDim.x) {
        const int r0 = (tile >> 4) * 32 + (wave >> 2) * 16, n0 = (tile & 15) * 64 + (wave & 3) * 16;
        const bf16_t* ap = A + (size_t)(MP + r0 + fr) * K + fq * 8; const bf16_t* bp = Bt + (size_t)(n0 + fr) * K + fq * 8;
        f32x4 acc0 = {0.f, 0.f, 0.f, 0.f}, acc1 = {0.f, 0.f, 0.f, 0.f};
        for (int k0 = 0; k0 < K; k0 += 256) {
            bf16x8 af[8], bfv[8];
#pragma unroll
            for (int u = 0; u < 8; ++u) { af[u] = *(const bf16x8*)(ap + k0 + 32 * u); bfv[u] = *(const bf16x8*)(bp + k0 + 32 * u); }
#pragma unroll
            for (int u = 0; u < 8; u += 2) { acc0 = __builtin_amdgcn_mfma_f32_16x16x32_bf16(bfv[u], af[u], acc0, 0, 0, 0); acc1 = __builtin_amdgcn_mfma_f32_16x16x32_bf16(bfv[u + 1], af[u + 1], acc1, 0, 0, 0); }
        }
        const f32x4 acc = acc0 + acc1;
        const int row = MP + r0 + fr, col = n0 + 4 * fq; const size_t e = (size_t)row * D + col;
        f32x4 v;
        if (MODE == 0) { v = acc + *(const f32x4*)(xs + (size_t)(r0 + fr) * D + col); u32x2 w; w.x = pk2(v[0], v[1]); w.y = pk2(v[2], v[3]); *(u32x2*)(X1B + e) = w; }
        else { const u32x2 xb = *(const u32x2*)(X1B + e); v = acc + (f32x4){bflo(xb.x), bfhi(xb.x), bflo(xb.y), bfhi(xb.y)}; *(f32x4*)(X + e) = v; }
        float sq = (v[0] * v[0] + v[1] * v[1]) + (v[2] * v[2] + v[3] * v[3]);
        sq += __shfl_xor(sq, 16); sq += __shfl_xor(sq, 32);
        if (fq == 0) atomicAdd(ss + row, sq);
    }
}

__device__ __forceinline__ void p0_transpose_item(const float* W, int K, int N, const float* gain, bf16_t* WT, LAS float* scr, int item, int lane) {
    const int nblk = N / 32, kb = item / nblk, nb = item % nblk, k0 = 64 * kb, n0 = 32 * nb;
    float wv[32];
#pragma unroll
    for (int i = 0; i < 32; ++i) { const int kk = 2 * i + (lane >> 5); wv[i] = W[(size_t)(k0 + kk) * N + n0 + (lane & 31)]; }
#pragma unroll
    for (int i = 0; i < 32; ++i) { const int kk = 2 * i + (lane >> 5); const float gk = gain ? gain[k0 + kk] : 1.0f; scr[kk * 33 + (lane & 31)] = wv[i] * gk; }
    LDS_WAIT(); asm volatile("" ::: "memory");
    const int c = lane & 7;
#pragma unroll
    for (int j = 0; j < 4; ++j) { const int n = (lane >> 3) + 8 * j; const LAS float* s = scr + (8 * c) * 33 + n;
        u32x4 o; o.x = pk2(s[0 * 33], s[1 * 33]); o.y = pk2(s[2 * 33], s[3 * 33]); o.z = pk2(s[4 * 33], s[5 * 33]); o.w = pk2(s[6 * 33], s[7 * 33]);
        *(u32x4*)(WT + (size_t)(n0 + n) * K + k0 + 8 * c) = o; }
    LDS_WAIT(); asm volatile("" ::: "memory");
}
__device__ __forceinline__ void p0_prologue(const Args& a, LAS unsigned char* lds) {
    const int tid = threadIdx.x, lane = tid & 63, wave = tid >> 6, G = gridDim.x;
    LAS float* scr = (LAS float*)(lds + wave * 16384);
    const int gw = blockIdx.x * NWAVES + wave, NGW = G * NWAVES;
    unsigned char* ws = a.ws;
    constexpr int I1 = (D / 64) * (2 * WL / 32);
    for (int it = gw; it < I1; it += NGW) p0_transpose_item(a.in[6], D, 2 * WL, a.in[5], (bf16_t*)(ws + WS_W1T), scr, it, lane);
    { bf16_t* wrt = (bf16_t*)(ws + WS_WRT); const int gt = blockIdx.x * NTHREADS + tid, NT = G * NTHREADS;
      for (int o = gt; o < 2 * NBLK * BW * BW; o += NT) { const int which = o / (NBLK * BW * BW), r = o % (NBLK * BW * BW), n = r / (BW * BW), j = (r / BW) % BW, i = r % BW;
          wrt[o] = (bf16_t)f2bf((which ? a.in[11] : a.in[9])[(n * BW + i) * BW + j]); }
      float* ss1 = (float*)(ws + WS_SS1); float* ss2 = (float*)(ws + WS_SS2);
      for (int o = gt; o < M; o += NT) { ss1[o] = 0.f; ss2[o] = 0.f; } }
    bf16_t* XA = (bf16_t*)(ws + WS_XA);
    for (int m = gw; m < M; m += NGW) {
        const float* xrow = m < MP ? a.in[0] + (size_t)m * D : a.in[1] + (size_t)(m - MP) * D;
        const f32x4* xr = (const f32x4*)xrow + lane; f32x4 v[4]; float s = 0.f;
#pragma unroll
        for (int j = 0; j < 4; ++j) { v[j] = xr[64 * j]; s += (v[j].x * v[j].x + v[j].y * v[j].y) + (v[j].z * v[j].z + v[j].w * v[j].w); }
        const float rstd = __builtin_amdgcn_rsqf(wave_sum(s) * (1.f / D) + EPS);
        unsigned long long* o8 = (unsigned long long*)(XA + (size_t)m * D) + lane;
#pragma unroll
        for (int j = 0; j < 4; ++j) o8[64 * j] = (unsigned long long)pk2(v[j].x * rstd, v[j].y * rstd) | ((unsigned long long)pk2(v[j].z * rstd, v[j].w * rstd) << 32);
    }
}

__device__ __forceinline__ void p0_late_weights(const Args& a, LAS unsigned char* lds, int rank, int count) {
    const int tid = threadIdx.x, lane = tid & 63, wave = tid >> 6;
    LAS float* scr = (LAS float*)(lds + wave * 16384);
    const int gw = rank * NWAVES + wave, NGW = count * NWAVES; unsigned char* ws = a.ws;
    constexpr int I2 = (WL / 64) * (D / 32), I3 = (D / 64) * (4 * INNER / 32), I4 = (INNER / 64) * (D / 32);
    for (int it = gw; it < I2 + I3 + I4; it += NGW) {
        int r = it;
        if (r < I2) { p0_transpose_item(a.in[14], WL, D, nullptr, (bf16_t*)(ws + WS_W2T), scr, r, lane); continue; } r -= I2;
        if (r < I3) { p0_transpose_item(a.in[15], D, 4 * INNER, a.in[5] + D, (bf16_t*)(ws + WS_W3T), scr, r, lane); continue; } r -= I3;
        p0_transpose_item(a.in[18], INNER, D, nullptr, (bf16_t*)(ws + WS_W4T), scr, r, lane);
    }
}

constexpr int P2_RAW = 0, P2_XC = 25600, P2_WT = 52224, P2_AB = 72192, P2_AGG = 121344, P2_PRM = 124416;
__device__ __forceinline__ void p2_lru(const Args& a, LAS unsigned char* lds) {
    const int tid = threadIdx.x, lane = tid & 63, wave = __builtin_amdgcn_readfirstlane(tid >> 6), fr = lane & 15, fq = lane >> 4;
    unsigned char* ws = a.ws;
    const bf16_t* XB = (const bf16_t*)(ws + WS_XB); const bf16_t* GS = (const bf16_t*)(ws + WS_GS); bf16_t* Y = (bf16_t*)(ws + WS_Y);
    const bf16_t* WRT = (const bf16_t*)(ws + WS_WRT);
    LAS float* prm = (LAS float*)(lds + P2_PRM);
    for (int item = blockIdx.x; item < 384; item += gridDim.x) {
        const bool smp = item >= 256;
        int n, half, nch, chunk0, row_base, b = 0;
        if (!smp) { b = item >> 5; n = (item >> 1) & 15; half = item & 1; nch = 16; chunk0 = 0; row_base = b * TP; }
        else { const int it = item - 256; n = it >> 3; half = (it >> 2) & 1; nch = 1; chunk0 = it & 3; row_base = MP; }
        const int ch0 = n * BW, oc0 = ch0 + half * 48;
        __syncthreads();
        for (int p = tid; p < 96 * 12; p += NTHREADS) { const int r = p / 12, cp = p % 12, which = r / 48, j = half * 48 + (r % 48);
            *(LAS u32x4*)(lds + P2_WT + r * 208 + cp * 16) = *(const u32x4*)(WRT + ((size_t)(which * NBLK + n) * BW + j) * BW + cp * 8); }
        const int rg = tid >> 4, cq = tid & 15;
        float cw0[6], cw1[6], cw2[6], cw3[6], cvb[6];
#pragma unroll
        for (int c = 0; c < 6; ++c) { const int ch = ch0 + 6 * cq + c; cw0[c] = a.in[7][ch]; cw1[c] = a.in[7][WL + ch]; cw2[c] = a.in[7][2 * WL + ch]; cw3[c] = a.in[7][3 * WL + ch]; cvb[c] = a.in[8][ch]; }
        if (tid < 48) { prm[480 + tid] = a.in[10][oc0 + tid]; prm[528 + tid] = a.in[12][oc0 + tid];
            const float lam = a.in[13][oc0 + tid]; const float sp = (lam > 15.f) ? __expf(-lam) : log1pf(__expf(-lam));
            prm[576 + tid] = -8.0f * sp * LOG2E; }
        float carry = 0.f;
        const int sr = tid / 12, scp = tid % 12;
        u32x4 pre[3], hal = {0u, 0u, 0u, 0u};
        { const int r0 = row_base + chunk0 * 128;
#pragma unroll
          for (int i = 0; i < 3; ++i) { const int p = tid + i * NTHREADS, r = p / 12, cp = p % 12; pre[i] = *(const u32x4*)(XB + (size_t)(r0 + r) * WL + ch0 + cp * 8); } }
        for (int ci = 0; ci < nch; ++ci) {
            const int chunk = chunk0 + ci, r0 = row_base + chunk * 128, rw = r0 + 16 * wave;
#pragma unroll
            for (int i = 0; i < 3; ++i) { const int p = tid + i * NTHREADS, r = p / 12, cp = p % 12; *(LAS u32x4*)(lds + P2_RAW + (r + 3) * 192 + cp * 16) = pre[i]; }
            if (tid < 36) *(LAS u32x4*)(lds + P2_RAW + sr * 192 + scp * 16) = hal;
            const int pt0 = lane / 6, pc0 = lane % 6, pt1 = (lane + 64) / 6, pc1 = (lane + 64) % 6;
            const u32x4 gs0 = *(const u32x4*)(GS + (size_t)(rw + pt0) * WL + oc0 + pc0 * 8);
            u32x4 gs1 = {0u, 0u, 0u, 0u}; if (lane < 32) gs1 = *(const u32x4*)(GS + (size_t)(rw + pt1) * WL + oc0 + pc1 * 8);
            if (ci + 1 < nch) {
#pragma unroll
                for (int i = 0; i < 3; ++i) { const int p = tid + i * NTHREADS, r = p / 12, cp = p % 12; pre[i] = *(const u32x4*)(XB + (size_t)(r0 + 128 + r) * WL + ch0 + cp * 8); }
                if (tid < 36) hal = *(const u32x4*)(XB + (size_t)(r0 + 125 + sr) * WL + ch0 + scp * 8); }
            __syncthreads();
            { float win[7][6];
#pragma unroll
              for (int r = 0; r < 7; ++r) {
                  if (smp && r < 3) { const float* bp = a.in[3] + ((size_t)((chunk * 32 + rg) * 3 + r) * WL + ch0 + 6 * cq);
#pragma unroll
                      for (int c = 0; c < 3; ++c) { const f32x2_ x = *(const f32x2_*)(bp + 2 * c); win[r][2 * c] = x[0]; win[r][2 * c + 1] = x[1]; } }
                  else {
#pragma unroll
                      for (int c = 0; c < 3; ++c) { const unsigned x = *(const LAS unsigned*)(lds + P2_RAW + (4 * rg + r) * 192 + cq * 12 + c * 4); win[r][2 * c] = bflo(x); win[r][2 * c + 1] = bfhi(x); } } }
#pragma unroll
              for (int r = 0; r < 4; ++r) { float o[6];
#pragma unroll
                  for (int c = 0; c < 6; ++c) o[c] = cvb[c] + cw0[c] * win[r][c] + cw1[c] * win[r + 1][c] + cw2[c] * win[r + 2][c] + cw3[c] * win[r + 3][c];
#pragma unroll
                  for (int c = 0; c < 3; ++c) *(LAS unsigned*)(lds + P2_XC + (4 * rg + r) * 208 + cq * 12 + c * 4) = pk2(o[2 * c], o[2 * c + 1]); } }
            __syncthreads();
            f32x4 acc[6];
#pragma unroll
            for (int nt = 0; nt < 6; ++nt) acc[nt] = (f32x4){0.f, 0.f, 0.f, 0.f};
#pragma unroll
            for (int kk = 0; kk < 3; ++kk) { const bf16x8 af = *(const LAS bf16x8*)(lds + P2_XC + (16 * wave + fr) * 208 + kk * 64 + fq * 16);
#pragma unroll
                for (int nt = 0; nt < 6; ++nt) { const bf16x8 bfr = *(const LAS bf16x8*)(lds + P2_WT + (nt * 16 + fr) * 208 + kk * 64 + fq * 16);
                    acc[nt] = __builtin_amdgcn_mfma_f32_16x16x32_bf16(bfr, af, acc[nt], 0, 0, 0); } }
            LAS float* abw = (LAS float*)(lds + P2_AB + wave * 6144);
#pragma unroll
            for (int nt = 0; nt < 3; ++nt) { const int cl = nt * 16 + 4 * fq;
                const u32x2 xq = *(const LAS u32x2*)(lds + P2_XC + (16 * wave + fr) * 208 + (half * 48 + cl) * 2);
                const float xc[4] = {bflo(xq.x), bfhi(xq.x), bflo(xq.y), bfhi(xq.y)}; f32x4 av, bv;
#pragma unroll
                for (int j = 0; j < 4; ++j) { const float r = sigmoidf_(acc[nt][j] + prm[480 + cl + j]), ig = sigmoidf_(acc[nt + 3][j] + prm[528 + cl + j]);
                    const float la = prm[576 + cl + j] * r, aa = ex2(la), om = 1.0f - aa * aa;
                    av[j] = aa; bv[j] = __builtin_amdgcn_sqrtf(fmaxf(om, 0.f)) * (ig * xc[j]); }
                *(LAS f32x4*)(abw + fr * 48 + cl) = av; *(LAS f32x4*)(abw + 768 + fr * 48 + cl) = bv; }
            LDS_WAIT(); asm volatile("" ::: "memory");
            const int cl = lane < 48 ? lane : 47;
            LAS float* agg = (LAS float*)(lds + P2_AGG);
            if (!smp) {
                float hloc[16], acum[16]; float Ac = 1.f, Bl = 0.f;
#pragma unroll
                for (int t = 0; t < 16; ++t) { const float at = abw[t * 48 + cl], bt = abw[768 + t * 48 + cl]; Bl = at * Bl + bt; Ac *= at; hloc[t] = Bl; acum[t] = Ac; }
                if (lane < 48) { agg[(wave * 2) * 48 + lane] = Ac; agg[(wave * 2 + 1) * 48 + lane] = Bl; }
                __syncthreads();
                float h = carry, hin = 0.f;
#pragma unroll
                for (int w = 0; w < 8; ++w) { if (w == wave) hin = h; h = agg[(w * 2) * 48 + cl] * h + agg[(w * 2 + 1) * 48 + cl]; }
                carry = h;
                if (lane < 48) {
#pragma unroll
                    for (int t = 0; t < 16; ++t) { const float hv = hloc[t] + acum[t] * hin; abw[768 + t * 48 + lane] = hv;
                        if (t == 15 && chunk == 15 && wave == 7) a.out[O_HP + (size_t)b * WL + oc0 + lane] = hv; } }
            } else {
                __syncthreads();
                float h = 0.f;
#pragma unroll
                for (int t = 0; t < 16; ++t) { const int sq = (chunk * 128 + 16 * wave + t) >> 2;
                    if ((t & 3) == 0) h = a.in[2][(size_t)sq * WL + oc0 + cl];
                    h = abw[t * 48 + cl] * h + abw[768 + t * 48 + cl];
                    if (lane < 48) { abw[768 + t * 48 + lane] = h; if ((t & 3) == 3) a.out[O_HS + (size_t)sq * WL + oc0 + lane] = h; } }
            }
            LDS_WAIT(); asm volatile("" ::: "memory");
            { const LAS float* hp = abw + 768 + pt0 * 48 + pc0 * 8; const f32x4 h0 = *(const LAS f32x4*)hp, h1 = *(const LAS f32x4*)(hp + 4);
              u32x4 w; w.x = pk2(h0[0] * bflo(gs0.x), h0[1] * bfhi(gs0.x)); w.y = pk2(h0[2] * bflo(gs0.y), h0[3] * bfhi(gs0.y)); w.z = pk2(h1[0] * bflo(gs0.z), h1[1] * bfhi(gs0.z)); w.w = pk2(h1[2] * bflo(gs0.w), h1[3] * bfhi(gs0.w));
              *(u32x4*)(Y + (size_t)(rw + pt0) * WL + oc0 + pc0 * 8) = w; }
            if (lane < 32) { const LAS float* hp = abw + 768 + pt1 * 48 + pc1 * 8; const f32x4 h0 = *(const LAS f32x4*)hp, h1 = *(const LAS f32x4*)(hp + 4);
              u32x4 w; w.x = pk2(h0[0] * bflo(gs1.x), h0[1] * bfhi(gs1.x)); w.y = pk2(h0[2] * bflo(gs1.y), h0[3] * bfhi(gs1.y)); w.z = pk2(h1[0] * bflo(gs1.z), h1[1] * bfhi(gs1.z)); w.w = pk2(h1[2] * bflo(gs1.w), h1[3] * bfhi(gs1.w));
              *(u32x4*)(Y + (size_t)(rw + pt1) * WL + oc0 + pc1 * 8) = w; }
        }
    }
}

constexpr int E1_QT = 0, E1_KT = 8704, E1_VT = 17408, E1_PL = 27648, E1_GT = 30208, E1_QE = 32256;
__device__ __forceinline__ void p5a_prep(const Args& a, LAS unsigned char* lds) {
    const int tid = threadIdx.x, lane = tid & 63, wave = __builtin_amdgcn_readfirstlane(tid >> 6), fr = lane & 15, fq = lane >> 4;
    const int k = tid & 127, tg = tid >> 7;
    unsigned char* ws = a.ws;
    const bf16_t* QB = (const bf16_t*)(ws + WS_QB); const bf16_t* VB = (const bf16_t*)(ws + WS_VB); const float* LG = a.out + O_SS;
    bf16_t* INTRA = (bf16_t*)(a.out + O_Y); unsigned char* OPI = ws + WS_OPI; float* DV = (float*)(ws + WS_DV);
    const int qoff = (((k >> 5) * 2 + ((k >> 4) & 1)) * 64 + 32 * ((k >> 2) & 1)) * 16 + ((k & 3) + 4 * ((k >> 3) & 1)) * 2;
    const int koff = ((8 + (k >> 5) * 2 + (tg >> 1)) * 64 + (k & 31) + 32 * (tg & 1)) * 16;
    LAS float* gt = (LAS float*)(lds + E1_GT);
    float lgn[8]; unsigned short qn[8], vn[8];
    if (blockIdx.x < 4096) { const int item = blockIdx.x, b = item >> 9, h = (item >> 6) & 7, c = item & 63; const size_t e0 = ((size_t)b * TP + c * 32 + 8 * tg) * INNER + h * DK + k;
#pragma unroll
        for (int i = 0; i < 8; ++i) { lgn[i] = LG[e0 + (size_t)i * INNER]; qn[i] = QB[e0 + (size_t)i * INNER]; vn[i] = VB[e0 + (size_t)i * INNER]; } }
    for (int item = blockIdx.x; item < 4096; item += gridDim.x) {
        const int b = item >> 9, h = (item >> 6) & 7, c = item & 63;
        const size_t rowb = (size_t)b * TP + c * 32, e0 = (rowb + 8 * tg) * INNER + h * DK + k;
        unsigned char* img = OPI + (size_t)item * OPI_BYTES;
        float lg[8], q[8]; unsigned short vv[8];
#pragma unroll
        for (int i = 0; i < 8; ++i) { lg[i] = lgn[i]; q[i] = bf2f(qn[i]); vv[i] = vn[i]; }
        float cs[8]; float run = 0.f;
#pragma unroll
        for (int i = 0; i < 8; ++i) { run += lg[i]; cs[i] = run; }
        gt[tg * 128 + k] = run;
        u32x4 vp; vp.x = vv[0] | ((unsigned)vv[1] << 16); vp.y = vv[2] | ((unsigned)vv[3] << 16); vp.z = vv[4] | ((unsigned)vv[5] << 16); vp.w = vv[6] | ((unsigned)vv[7] << 16);
        *(LAS u32x4*)(lds + E1_VT + k * 80 + tg * 16) = vp;
        __syncthreads();
        { const int nitem = item + gridDim.x;
          if (nitem < 4096) { const int nb = nitem >> 9, nh = (nitem >> 6) & 7, nc = nitem & 63; const size_t ne0 = ((size_t)nb * TP + nc * 32 + 8 * tg) * INNER + nh * DK + k;
#pragma unroll
              for (int i = 0; i < 8; ++i) { lgn[i] = LG[ne0 + (size_t)i * INNER]; qn[i] = QB[ne0 + (size_t)i * INNER]; vn[i] = VB[ne0 + (size_t)i * INNER]; } } }
        const float g0 = gt[k], g1 = gt[128 + k], g2 = gt[256 + k], g3 = gt[384 + k];
        const float off = (tg > 0 ? g0 : 0.f) + (tg > 1 ? g1 : 0.f) + (tg > 2 ? g2 : 0.f), tot = (g0 + g1) + (g2 + g3), mid = g0 + g1;
        unsigned short kep[8];
#pragma unroll
        for (int i = 0; i < 8; ++i) { const float cum = off + cs[i], kk = 1.0f - ex2(lg[i]);
            const float qt = q[i] * ex2(fminf(cum - mid, 115.f)), kt = kk * ex2(fminf(mid - cum, 115.f));
            *(LAS unsigned short*)(lds + E1_QT + (8 * tg + i) * 272 + k * 2) = (unsigned short)f2bf(qt);
            *(LAS unsigned short*)(lds + E1_KT + (8 * tg + i) * 272 + k * 2) = (unsigned short)f2bf(kt);
            *(LAS unsigned short*)(lds + E1_QE + (8 * tg + i) * 272 + k * 2) = (unsigned short)f2bf(q[i] * ex2(cum));
            kep[i] = (unsigned short)f2bf(kk * ex2(tot - cum)); }
        u32x4 kp; kp.x = kep[0] | ((unsigned)kep[1] << 16); kp.y = kep[2] | ((unsigned)kep[3] << 16); kp.z = kep[4] | ((unsigned)kep[5] << 16); kp.w = kep[6] | ((unsigned)kep[7] << 16);
        *(u32x4*)(img + koff) = kp;
        *(u32x4*)(img + koff + 8 * 1024) = vp;
        if (tg == 0) DV[(size_t)item * 128 + k] = ex2(tot);
        __syncthreads();
        { const int f = tid >> 6, tq = lane & 31, gq = lane >> 5;
          const LAS unsigned char* qr = lds + E1_QE + tq * 272 + (f * 16 + 4 * gq) * 2;
          const u32x2 lo = *(const LAS u32x2*)qr, hi = *(const LAS u32x2*)(qr + 16);
          *(u32x4*)(img + tid * 16) = (u32x4){lo.x, lo.y, hi.x, hi.y}; }
        if (wave < 3) { const int mt = wave > 0 ? 1 : 0, st = wave > 1 ? 1 : 0; f32x4 acc = {0.f, 0.f, 0.f, 0.f};
#pragma unroll
            for (int ks = 0; ks < 4; ++ks) { const bf16x8 kf = *(const LAS bf16x8*)(lds + E1_KT + (16 * st + fr) * 272 + ks * 64 + fq * 16), qf = *(const LAS bf16x8*)(lds + E1_QT + (16 * mt + fr) * 272 + ks * 64 + fq * 16);
                acc = __builtin_amdgcn_mfma_f32_16x16x32_bf16(kf, qf, acc, 0, 0, 0); }
            const int t = 16 * mt + fr, s0 = 16 * st + 4 * fq;
            u32x2 w; w.x = pk2(s0 <= t ? acc[0] : 0.f, s0 + 1 <= t ? acc[1] : 0.f); w.y = pk2(s0 + 2 <= t ? acc[2] : 0.f, s0 + 3 <= t ? acc[3] : 0.f);
            *(LAS u32x2*)(lds + E1_PL + t * 80 + s0 * 2) = w;
        } else if (wave == 3) { *(LAS u32x2*)(lds + E1_PL + fr * 80 + (16 + 4 * fq) * 2) = (u32x2){0u, 0u}; }
        __syncthreads();
        { const bf16x8 vf = *(const LAS bf16x8*)(lds + E1_VT + (16 * wave + fr) * 80 + fq * 16);
#pragma unroll
          for (int mt = 0; mt < 2; ++mt) { const bf16x8 pf = *(const LAS bf16x8*)(lds + E1_PL + (16 * mt + fr) * 80 + fq * 16);
              const f32x4 o = __builtin_amdgcn_mfma_f32_16x16x32_bf16(vf, pf, (f32x4){0.f, 0.f, 0.f, 0.f}, 0, 0, 0);
              u32x2 w; w.x = pk2(o[0], o[1]); w.y = pk2(o[2], o[3]);
              *(u32x2*)(INTRA + (rowb + 16 * mt + fr) * INNER + h * DK + 16 * wave + 4 * fq) = w; } }
    }
}

struct Pre6 { u32x4 a[2]; u32x4 v; u32x4 d; };
constexpr int R6_SLOT = 18944;
__device__ __forceinline__ void p6_load(Pre6& f, const unsigned char* OPI, const float* DV, int item, int vt, int tid) {
    const unsigned char* img = OPI + (size_t)item * OPI_BYTES;
    f.a[0] = *(const u32x4*)(img + tid * 16); f.a[1] = *(const u32x4*)(img + (tid + NTHREADS) * 16);
    if (tid < 128) f.v = *(const u32x4*)(img + (16 * 64 + vt * 128 + tid) * 16);
    if (tid < 32) f.d = *(const u32x4*)(DV + (size_t)item * 128 + tid * 4);
}
__device__ __forceinline__ void p6_stage(const Pre6& f, LAS unsigned char* slot, int tid) {
    *(LAS u32x4*)(slot + tid * 16) = f.a[0]; *(LAS u32x4*)(slot + (tid + NTHREADS) * 16) = f.a[1];
    if (tid < 128) *(LAS u32x4*)(slot + 16384 + tid * 16) = f.v;
    if (tid < 32) *(LAS u32x4*)(slot + 18432 + tid * 16) = f.d;
}
__device__ __forceinline__ void p6_step(const LAS unsigned char* slot, f32x16& S, LAS float* OP, bf16_t* INTER, int c, size_t eoff, int wave, int lane, int et, int ev) {
    const int buf = c & 1, l32 = lane & 31, g = lane >> 5;
    if (wave < 4) { const int kt = wave;
        f32x16 acc;
#pragma unroll
        for (int i = 0; i < 16; ++i) acc[i] = 0.f;
#pragma unroll
        for (int kp = 0; kp < 2; ++kp) {
            const bf16x8 qf = *(const LAS bf16x8*)(slot + ((kt * 2 + kp) * 64 + lane) * 16);
            u32x4 sp; sp.x = pk2(S[8 * kp + 0], S[8 * kp + 1]); sp.y = pk2(S[8 * kp + 2], S[8 * kp + 3]); sp.z = pk2(S[8 * kp + 4], S[8 * kp + 5]); sp.w = pk2(S[8 * kp + 6], S[8 * kp + 7]);
            acc = __builtin_amdgcn_mfma_f32_32x32x16_bf16(qf, __builtin_bit_cast(bf16x8, sp), acc, 0, 0, 0); }
        LAS float* opw = OP + ((buf * 4 + kt) * 32) * 32 + l32;
#pragma unroll
        for (int r = 0; r < 16; ++r) opw[((r & 3) + 8 * (r >> 2) + 4 * g) * 32] = acc[r];
        const LAS float* dl = (const LAS float*)(slot + 18432);
#pragma unroll
        for (int j = 0; j < 4; ++j) { const f32x4 dd = *(const LAS f32x4*)(dl + kt * 32 + 4 * g + 8 * j);
            S[4 * j] *= dd[0]; S[4 * j + 1] *= dd[1]; S[4 * j + 2] *= dd[2]; S[4 * j + 3] *= dd[3]; }
#pragma unroll
        for (int kp = 0; kp < 2; ++kp) { const bf16x8 kf = *(const LAS bf16x8*)(slot + ((8 + kt * 2 + kp) * 64 + lane) * 16), vf = *(const LAS bf16x8*)(slot + 16384 + (kp * 64 + lane) * 16);
            S = __builtin_amdgcn_mfma_f32_32x32x16_bf16(kf, vf, S, 0, 0, 0); }
    }
    __syncthreads();
    const LAS float* p = OP + ((buf * 4) * 32 + et) * 32 + ev;
    const f32x2_ a0 = *(const LAS f32x2_*)p, a1 = *(const LAS f32x2_*)(p + 1024), a2 = *(const LAS f32x2_*)(p + 2048), a3 = *(const LAS f32x2_*)(p + 3072);
    *(unsigned*)(INTER + eoff) = pk2((a0[0] + a1[0]) + (a2[0] + a3[0]), (a0[1] + a1[1]) + (a2[1] + a3[1]));
}
__device__ __forceinline__ void p6_chain(const Args& a, LAS unsigned char* lds) {
    const int tid = threadIdx.x, lane = tid & 63, wave = __builtin_amdgcn_readfirstlane(tid >> 6);
    unsigned char* ws = a.ws;
    bf16_t* INTER = (bf16_t*)(ws + WS_QB); const unsigned char* OPI = ws + WS_OPI; const float* DV = (const float*)(ws + WS_DV);
    LAS float* OP = (LAS float*)lds;
    LAS unsigned char* ring = lds + 32768;
    for (int unit = blockIdx.x; unit < 256; unit += gridDim.x) {
        const int q = unit >> 2, vt = unit & 3, b = q >> 3, h = q & 7, l32 = lane & 31, g = lane >> 5;
        const int et = tid >> 4, ev = (tid & 15) * 2;
        const size_t rbase = (size_t)b * TP; const int item0 = q * 64;
        f32x16 S;
#pragma unroll
        for (int i = 0; i < 16; ++i) S[i] = 0.f;
        __syncthreads();
        Pre6 f0, f1, f2, f3, f4;
#define P6_EOFF(c) ((rbase + (size_t)(c) * 32 + et) * INNER + h * DK + vt * 32 + ev)
#define P6_LOAD(f, c) p6_load(f, OPI, DV, item0 + (c), vt, tid)
#define P6_STAGE(f, c) p6_stage(f, ring + ((c) & 1) * R6_SLOT, tid)
#define P6_STEP(c) p6_step(ring + ((c) & 1) * R6_SLOT, S, OP, INTER, (c), P6_EOFF(c), wave, lane, et, ev)
        P6_LOAD(f0, 0); P6_LOAD(f1, 1); P6_LOAD(f2, 2); P6_LOAD(f3, 3); P6_LOAD(f4, 4);
        P6_STAGE(f0, 0);
        __syncthreads();
        for (int c = 0; c < 60; c += 5) {
            P6_STAGE(f1, c + 1); P6_STEP(c);     if (c + 5 < 64) P6_LOAD(f0, c + 5);
            P6_STAGE(f2, c + 2); P6_STEP(c + 1); if (c + 6 < 64) P6_LOAD(f1, c + 6);
            P6_STAGE(f3, c + 3); P6_STEP(c + 2); if (c + 7 < 64) P6_LOAD(f2, c + 7);
            P6_STAGE(f4, c + 4); P6_STEP(c + 3); if (c + 8 < 64) P6_LOAD(f3, c + 8);
            P6_STAGE(f0, c + 5); P6_STEP(c + 4); if (c + 9 < 64) P6_LOAD(f4, c + 9);
        }
        P6_STAGE(f1, 61); P6_STEP(60);
        P6_STAGE(f2, 62); P6_STEP(61);
        P6_STAGE(f3, 63); P6_STEP(62);
        P6_STEP(63);
#undef P6_EOFF
#undef P6_LOAD
#undef P6_STAGE
#undef P6_STEP
        if (wave < 4) { float* so = a.out + O_SP + (size_t)q * DK * DK;
#pragma unroll
            for (int r = 0; r < 16; ++r) so[(size_t)(wave * 32 + (r & 3) + 8 * (r >> 2) + 4 * g) * DK + vt * 32 + l32] = S[r]; }
    }
}
__device__ __forceinline__ void p6_norm(const Args& a, size_t out_off) {
    const int lane = threadIdx.x & 63, gw = blockIdx.x * NWAVES + (threadIdx.x >> 6), NGW = gridDim.x * NWAVES;
    unsigned char* ws = a.ws;
    const bf16_t* O2 = (const bf16_t*)(ws + WS_QB); bf16_t* O2w = (bf16_t*)(ws + out_off); const bf16_t* INTRA = (const bf16_t*)(a.out + O_Y); const bf16_t* GB = (const bf16_t*)(ws + WS_GB);
    float gn[16];
#pragma unroll
    for (int j = 0; j < 4; ++j) { const f32x4 t4 = *(const f32x4*)(a.in[17] + lane * 16 + 4 * j); gn[4 * j] = t4[0]; gn[4 * j + 1] = t4[1]; gn[4 * j + 2] = t4[2]; gn[4 * j + 3] = t4[3]; }
    for (int m = gw; m < MP; m += NGW) {
        const size_t e = (size_t)m * INNER + lane * 16;
        const u32x4 x0 = *(const u32x4*)(O2 + e), x1 = *(const u32x4*)(O2 + e + 8), y0 = *(const u32x4*)(INTRA + e), y1 = *(const u32x4*)(INTRA + e + 8), g0 = *(const u32x4*)(GB + e), g1 = *(const u32x4*)(GB + e + 8);
        const unsigned xs[8] = {x0.x, x0.y, x0.z, x0.w, x1.x, x1.y, x1.z, x1.w}, ys[8] = {y0.x, y0.y, y0.z, y0.w, y1.x, y1.y, y1.z, y1.w}, gs[8] = {g0.x, g0.y, g0.z, g0.w, g1.x, g1.y, g1.z, g1.w};
        float o[16]; float sq = 0.f;
#pragma unroll
        for (int j = 0; j < 8; ++j) { o[2 * j] = bflo(xs[j]) + bflo(ys[j]); o[2 * j + 1] = bfhi(xs[j]) + bfhi(ys[j]); sq += o[2 * j] * o[2 * j] + o[2 * j + 1] * o[2 * j + 1]; }
        sq += __shfl_xor(sq, 1); sq += __shfl_xor(sq, 2); sq += __shfl_xor(sq, 4);
        const float rstd = __builtin_amdgcn_rsqf(sq * (1.0f / DK) + EPS);
        unsigned w[8];
#pragma unroll
        for (int j = 0; j < 8; ++j) w[j] = pk2(o[2 * j] * rstd * gn[2 * j] * bflo(gs[j]), o[2 * j + 1] * rstd * gn[2 * j + 1] * bfhi(gs[j]));
        *(u32x4*)(O2w + e) = (u32x4){w[0], w[1], w[2], w[3]}; *(u32x4*)(O2w + e + 8) = (u32x4){w[4], w[5], w[6], w[7]};
    }
}
__device__ __forceinline__ void p5b_sample(const Args& a, LAS unsigned char* lds, size_t o2_off) {
    const int tid = threadIdx.x, lane = tid & 63, wave = __builtin_amdgcn_readfirstlane(tid >> 6);
    unsigned char* ws = a.ws;
    const bf16_t* QB = (const bf16_t*)(ws + WS_QB); const bf16_t* VB = (const bf16_t*)(ws + WS_VB); const bf16_t* GB = (const bf16_t*)(ws + WS_GB);
    bf16_t* O2 = (bf16_t*)(ws + o2_off); const float* og = a.in[17];
    {
        const float* LGs = (const float*)(ws + WS_LGS); const float* S0 = a.in[4]; float* S1 = a.out + O_SS;
        LAS float* gq = (LAS float*)lds; LAS float* gg = gq + 512; LAS float* gk = gq + 1024; LAS float* gv = gq + 1536;
        LAS float* ops = gq + 2048;
        LAS float* red = ops + 8192;
        for (int it = blockIdx.x; it < NSQ * NH; it += gridDim.x) {
            const int s = it >> 3, h = it & 7;
            __syncthreads();
            { const int t = tid >> 7, k = tid & 127; const size_t rs = (size_t)(s * 4 + t) * INNER + h * DK + k;
              const float gl = ex2(LGs[rs]); gg[tid] = gl; gk[tid] = 1.0f - gl; gq[tid] = bf2f(QB[(size_t)MP * INNER + rs]); gv[tid] = bf2f(VB[(size_t)MP * INNER + rs]); }
            const int v4 = (tid & 31) * 4, kg = tid >> 5;
            f32x4 St[8]; const size_t sb = ((size_t)it * DK + kg * 8) * DK + v4;
#pragma unroll
            for (int i = 0; i < 8; ++i) St[i] = *(const f32x4*)(S0 + sb + (size_t)i * DK);
            __syncthreads();
#pragma unroll
            for (int t = 0; t < 4; ++t) { const f32x4 vv = *(const LAS f32x4*)(gv + t * 128 + v4); f32x4 op = {0.f, 0.f, 0.f, 0.f};
#pragma unroll
                for (int i = 0; i < 8; ++i) { const int k = t * 128 + kg * 8 + i; const float g_ = gg[k], k_ = gk[k], q_ = gq[k];
                    St[i] = St[i] * g_ + vv * k_; op += St[i] * q_; }
                *(LAS f32x4*)(ops + (kg * 4 + t) * 128 + v4) = op; }
#pragma unroll
            for (int i = 0; i < 8; ++i) *(f32x4*)(S1 + sb + (size_t)i * DK) = St[i];
            __syncthreads();
            { const int t = tid >> 7, v = tid & 127; float o = 0.f;
#pragma unroll
              for (int kq = 0; kq < 16; ++kq) o += ops[(kq * 4 + t) * 128 + v];
              const float sq = wave_sum(o * o);
              if (lane == 0) red[wave] = sq;
              __syncthreads();
              const float rstd = __builtin_amdgcn_rsqf((red[2 * t] + red[2 * t + 1]) * (1.0f / DK) + EPS);
              const size_t rs = (size_t)(MP + s * 4 + t) * INNER + h * DK + v;
              O2[rs] = (bf16_t)f2bf(o * rstd * og[h * DK + v] * bf2f(GB[rs])); }
        }
    }
}
__device__ __forceinline__ void p7_final(const Args& a, float* outp) {
    const int lane = threadIdx.x & 63, gw = blockIdx.x * NWAVES + (threadIdx.x >> 6), NGW = gridDim.x * NWAVES;
    const float* ss2 = (const float*)(a.ws + WS_SS2); const f32x4* fg = (const f32x4*)a.in[19] + lane;
    f32x4 gn[4];
#pragma unroll
    for (int j = 0; j < 4; ++j) gn[j] = fg[64 * j];
    for (int m = gw; m < M; m += NGW) {
        const float rstd = __builtin_amdgcn_rsqf(ss2[m] * (1.f / D) + EPS);
        const f32x4* xr = (const f32x4*)(a.out + (size_t)m * D) + lane; f32x4* xo = (f32x4*)(outp + (size_t)m * D) + lane;
#pragma unroll
        for (int j = 0; j < 4; ++j) xo[64 * j] = xr[64 * j] * rstd * gn[j];
    }
}

#define XB_TMO      128
#define XB_XCNT(j)  (256  + 64 * (j))
#define XB_XSUB(j)  (1280 + 64 * (j))
#define XB_XGEN(j)  (2304 + 64 * (j))
#define XB_TOP      3328
#define XB_TOPGEN   3392
#define XCD_BAR_WORDS 3456
#define XB_SPIN_CAP (1u << 18)

__device__ __forceinline__ unsigned xb_ld(unsigned* p)              { return __hip_atomic_load(p, __ATOMIC_RELAXED, __HIP_MEMORY_SCOPE_AGENT); }
__device__ __forceinline__ unsigned xb_add(unsigned* p, unsigned v) { return __hip_atomic_fetch_add(p, v, __ATOMIC_RELAXED, __HIP_MEMORY_SCOPE_AGENT); }
__device__ __forceinline__ unsigned xb_xcc_id() { return (unsigned)__builtin_amdgcn_s_getreg((3 << 11) | 20) & 0xFu; }
#define XB_SPIN(cond, bar) do { unsigned _sp = 0; while (cond) { __builtin_amdgcn_s_sleep(1); \
    if ((++_sp & 255u) == 0u) { if (xb_ld(&(bar)[XB_TMO])) break; if (_sp > XB_SPIN_CAP) { atomicAdd(&(bar)[XB_TMO], 1u); break; } } } } while (0)

struct XcdBarrier {
    unsigned* bar; unsigned x;
    volatile LAS unsigned* st;
};

__device__ __forceinline__ XcdBarrier xcd_barrier_post(unsigned* bar, volatile LAS unsigned* st) {
    XcdBarrier b; b.bar = bar; b.x = xb_xcc_id(); b.st = st;
    if (threadIdx.x == 0) (void)xb_add(&bar[XB_XCNT(b.x)], 1u);
    return b;
}
__device__ __forceinline__ void xcd_barrier_complete(unsigned* bar, unsigned x, unsigned& nloc, unsigned& nx) {
    const unsigned G = gridDim.x * gridDim.y * gridDim.z;
    unsigned sum, cnt, mine, sp = 0u;
    for (;;) {
        sum = 0u; cnt = 0u; mine = 0u;
#pragma unroll
        for (unsigned j = 0; j < 16; ++j) { const unsigned c = xb_ld(&bar[XB_XCNT(j)]); sum += c; cnt += (c > 0u) ? 1u : 0u; mine = (j == x) ? c : mine; }
        if (sum == G) break;
        __builtin_amdgcn_s_sleep(1);
        if ((++sp & 255u) == 0u) { if (xb_ld(&bar[XB_TMO])) break; if (sp > XB_SPIN_CAP) { atomicAdd(&bar[XB_TMO], 1u); break; } }
    }
    nloc = mine > 0u ? mine : 1u; nx = cnt > 0u ? cnt : 1u;
}

__device__ __forceinline__ void xcd_barrier(const XcdBarrier& b) {
    asm volatile("s_waitcnt vmcnt(0)" ::: "memory");
    __syncthreads();
    if (threadIdx.x == 0) {
        unsigned* bar = b.bar;
        __builtin_amdgcn_s_waitcnt(0);
        unsigned nloc = b.st[0], nx = b.st[1];
        if (nloc == 0u) { xcd_barrier_complete(bar, b.x, nloc, nx); b.st[0] = nloc; b.st[1] = nx; }
        const unsigned old = xb_add(&bar[XB_XSUB(b.x)], 1u);
        const unsigned gen = old / nloc;
        if (old + 1u == (gen + 1u) * nloc) {
            __builtin_amdgcn_fence(__ATOMIC_RELEASE, "agent");
            asm volatile("s_waitcnt vmcnt(0)" ::: "memory");
            const unsigned og = xb_add(&bar[XB_TOP], 1u);
            const unsigned tg = og / nx;
            if (og + 1u == (tg + 1u) * nx) xb_add(&bar[XB_TOPGEN], 1u);
            else XB_SPIN(xb_ld(&bar[XB_TOPGEN]) == tg, bar);
            __builtin_amdgcn_fence(__ATOMIC_ACQUIRE, "agent");
            xb_add(&bar[XB_XGEN(b.x)], 1u);
            asm volatile("s_waitcnt vmcnt(0)" ::: "memory");
        } else {
            XB_SPIN(xb_ld(&bar[XB_XGEN(b.x)]) == gen, bar);
            __builtin_amdgcn_fence(__ATOMIC_ACQUIRE, "agent");
            asm volatile("s_waitcnt vmcnt(0)" ::: "memory");
        }
    }
    __syncthreads();
}

__global__ void __launch_bounds__(NTHREADS, 2) mk_fwd(Args a) {
    extern __shared__ __attribute__((aligned(16))) unsigned char lds_raw[];
    LAS unsigned char* lds = (LAS unsigned char*)lds_raw;
    unsigned char* ws = a.ws; const int G = gridDim.x, lo = a.ph_lo, hi = a.ph_hi;
#define IN(p) (lo <= (p) && (p) < hi)
#if MK_USE_CG
    cg::grid_group grid = cg::this_grid();
#define SEAM(p) do { if (IN(p) && IN((p) + 1)) grid.sync(); } while (0)
#else
    volatile LAS unsigned* misc = (volatile LAS unsigned*)(lds + LDS_BYTES - 64);
    if (threadIdx.x < 16) misc[threadIdx.x] = 0u;
    __syncthreads();
    XcdBarrier bar; bar.bar = (unsigned*)ws; bar.x = 0; bar.st = nullptr;
    if (hi - lo > 1) bar = xcd_barrier_post((unsigned*)ws, misc);
#define SEAM(p) do { if (IN(p) && IN((p) + 1)) xcd_barrier(bar); } while (0)
#endif
    if (IN(0)) { p0_prologue(a, lds); if (MK_DUP == 0) p0_prologue(a, lds); }
    SEAM(0);
    if (IN(1)) { pg8::Gemm g{(const bf16_t*)(ws + WS_XA), (const bf16_t*)(ws + WS_W1T), M, 2 * WL, D}; pg8::StaticOrder S; S.init(M, 2 * WL, G, (int)blockIdx.x);
        Epi1 E{(bf16_t*)(ws + WS_XB), (bf16_t*)(ws + WS_GS), a.out + O_BP, a.out + O_BS};
        pg8::gemm_phase<Epi1, pg8::StaticOrder, true, true>(lds, g, S, E);
        { const int extra = S.nwg % G;
          if ((int)blockIdx.x >= extra) p0_late_weights(a, lds, (int)blockIdx.x - extra, G - extra); } }
    SEAM(1);
    if (IN(2)) { p2_lru(a, lds); if (MK_DUP == 2) p2_lru(a, lds); }
    SEAM(2);
    if (IN(3)) { pg8::Gemm g{(const bf16_t*)(ws + WS_Y), (const bf16_t*)(ws + WS_W2T), MP, D, WL}; pg8::StaticOrder S; S.init(MP, D, G, (int)blockIdx.x);
        Epi2 E{a.in[0], a.in[1], a.out + O_Y, (bf16_t*)(ws + WS_XA), (float*)(ws + WS_SS1)};
        pg8::gemm_phase<Epi2, pg8::StaticOrder, true, true>(lds, g, S, E);
        small_gemm_sample<0>((const bf16_t*)(ws + WS_Y), (const bf16_t*)(ws + WS_W2T), WL, a.in[1], a.out + O_Y, (bf16_t*)(ws + WS_XA), (float*)(ws + WS_SS1)); }
    SEAM(3);
    if (IN(4)) { pg8::Gemm g{(const bf16_t*)(ws + WS_XA), (const bf16_t*)(ws + WS_W3T), M, 4 * INNER, D}; pg8::StaticOrder S; S.init(M, 4 * INNER, G, (int)blockIdx.x);
        Epi3 E{(const float*)(ws + WS_SS1), a.in[16], (bf16_t*)(ws + WS_QB), (bf16_t*)(ws + WS_VB), (bf16_t*)(ws + WS_GB), a.out + O_SS, (float*)(ws + WS_LGS)};
        pg8::gemm_phase<Epi3, pg8::StaticOrder, true, true>(lds, g, S, E); if (MK_DUP == 4) pg8::gemm_phase<Epi3, pg8::StaticOrder, true, true>(lds, g, S, E); }
    SEAM(4);
    if (IN(5)) { p5a_prep(a, lds); if (MK_DUP == 5) p5a_prep(a, lds); if (hi - lo > 1) xcd_barrier(bar); p5b_sample(a, lds, WS_QB); }
    SEAM(5);
    if (IN(6)) { p6_chain(a, lds); if (MK_DUP == 6) p6_chain(a, lds); if (hi - lo > 1) xcd_barrier(bar); if (MK_DUP == 11) p6_norm(a, WS_VB); p6_norm(a, WS_QB); }
    SEAM(6);
    if (IN(7)) { pg8::Gemm g{(const bf16_t*)(ws + WS_QB), (const bf16_t*)(ws + WS_W4T), MP, D, INNER}; pg8::StaticOrder S; S.init(MP, D, G, (int)blockIdx.x);
        Epi4 E{(const bf16_t*)(ws + WS_XA), (float*)(ws + WS_SS2), a.out + O_Y};
        pg8::gemm_phase<Epi4, pg8::StaticOrder, true, true>(lds, g, S, E);
        small_gemm_sample<1>((const bf16_t*)(ws + WS_QB), (const bf16_t*)(ws + WS_W4T), INNER, nullptr, a.out + O_Y, (const bf16_t*)(ws + WS_XA), (float*)(ws + WS_SS2)); }
    SEAM(7);
    if (MK_DUP == 9 && hi - lo > 1) { xcd_barrier(bar); xcd_barrier(bar); xcd_barrier(bar); xcd_barrier(bar); }
    if (IN(8)) { if (MK_DUP == 8) p7_final(a, (float*)(ws + WS_VB)); p7_final(a, a.out); }
#undef IN
#undef SEAM
}

extern "C" void kernel_launch(void* const* d_in, const int* in_sizes, int n_in, void* d_out, int out_size, void* d_ws, size_t ws_size, hipStream_t stream) {
    static int grid = 0;
    if (grid == 0) {
        int dev = 0, cus = 0, per_cu = 0;
        if (n_in != 20 || out_size != 35962880 || ws_size < WS_END) { fprintf(stderr, "kernel_launch: unexpected shapes (n_in %d out %d ws %zu)\n", n_in, out_size, ws_size); grid = -1; return; }
        hipGetDevice(&dev); hipDeviceGetAttribute(&cus, hipDeviceAttributeMultiprocessorCount, dev);
        if (hipFuncSetAttribute((const void*)mk_fwd, hipFuncAttributeMaxDynamicSharedMemorySize, LDS_BYTES) != hipSuccess) { fprintf(stderr, "kernel_launch: hipFuncSetAttribute failed\n"); grid = -1; return; }
        if (hipOccupancyMaxActiveBlocksPerMultiprocessor(&per_cu, (const void*)mk_fwd, NTHREADS, LDS_BYTES) != hipSuccess || per_cu < 1) { fprintf(stderr, "kernel_launch: occupancy query says %d\n", per_cu); grid = -1; (void)hipGetLastError(); return; }
        grid = cus;
        if (grid < 128) { fprintf(stderr, "kernel_launch: only %d CUs\n", grid); grid = -1; return; }
    }
    if (grid < 0) return;
    Args a{};
    for (int i = 0; i < 20; ++i) a.in[i] = (const float*)d_in[i];
    a.out = (float*)d_out; a.ws = (unsigned char*)d_ws;
#if MK_LAUNCHES == 1
    a.ph_lo = 0; a.ph_hi = NPHASE;
#if !MK_USE_CG
    if (hipMemsetAsync(d_ws, 0, 65536, stream) != hipSuccess) { fprintf(stderr, "kernel_launch: memset of the barrier words failed\n"); return; }
#endif
    void* args[] = {&a};
    hipError_t e = hipLaunchCooperativeKernel((const void*)mk_fwd, dim3(grid), dim3(NTHREADS), args, LDS_BYTES, stream);
    if (e != hipSuccess) fprintf(stderr, "cooperative launch failed: %s (grid %d)\n", hipGetErrorString(e), grid);
#else
    for (int p = 0; p < NPHASE; ++p) { a.ph_lo = p; a.ph_hi = p + 1;
        hipLaunchKernelGGL(mk_fwd, dim3(grid), dim3(NTHREADS), LDS_BYTES, stream, a); }
#endif
}
```

```cpp
#include <hip/hip_runtime.h>
#include <hip/hip_cooperative_groups.h>
#include <cstdio>
#include <cstdint>
namespace cg = cooperative_groups;
namespace pg8 {
#define PG8_LAS __attribute__((address_space(3)))
typedef unsigned short bf16_t;
typedef short bf16x8 __attribute__((ext_vector_type(8)));
typedef float f32x4 __attribute__((ext_vector_type(4)));
typedef unsigned u32x4 __attribute__((ext_vector_type(4)));
constexpr int BM = 256, BK = 64, HALF = 128, HTB = HALF * BK * 2  , STAGE_BYTES = 8 * HTB, NXCD = 8, WGM = 8;

__host__ __device__ __forceinline__ int lds_byte(int r, int c) { const int st = (r >> 4) * 2 + (c >> 5), rr = r & 15, cc = c & 31, ob = rr * 64 + cc * 2; return st * 1024 + (ob ^ (((ob >> 9) & 1) << 5)); }
__host__ __device__ __forceinline__ void stage_rc(int b, int& R, int& C) { const int st = b / 1024, sb = b % 1024, swz = sb ^ (((sb >> 9) & 1) << 5); R = (st >> 1) * 16 + swz / 64; C = (st & 1) * 32 + (swz % 64) / 2; }
__host__ __device__ __forceinline__ int perm32(int rho) { const int n = rho >> 4, i = rho & 15; return 8 * (i >> 2) + 4 * n + (i & 3); }

struct Unit { int pm, pn; };
struct Gemm { const bf16_t* A; const bf16_t* Bt; int M, N, K; };

struct StaticOrder {
    int nM, nN, nwg, G, c;
    __host__ __device__ void init(int M, int N, int G_, int c_) { nM = M / BM; nN = N / BM; nwg = nM * nN; G = G_; c = c_; }
    __host__ __device__ bool next(int i, Unit& u) const {
        const long L = (long)i * G + c; if (L >= nwg) return false;
        int wgid = (int)L; { const int q = nwg / NXCD, r = nwg % NXCD, xcd = wgid % NXCD, off = wgid / NXCD; wgid = (xcd < r ? xcd * (q + 1) : r * (q + 1) + (xcd - r) * q) + off; }
        const int nig = WGM * nN, gid = wgid / nig, fm = gid * WGM, gsz = (nM - fm) < WGM ? (nM - fm) : WGM;
        u.pm = fm + ((wgid % nig) % gsz); u.pn = (wgid % nig) / gsz; return true;
    }
    __device__ __forceinline__ void a_ready(const Unit&) const {}
    __device__ __forceinline__ void done(const Unit&) const {}
};

typedef float f32x2c __attribute__((ext_vector_type(2)));
typedef __bf16 bf16x2c __attribute__((ext_vector_type(2)));
__device__ __forceinline__ unsigned cvt_pk_bf16(float lo, float hi) { const f32x2c v = {lo, hi}; return __builtin_bit_cast(unsigned, __builtin_convertvector(v, bf16x2c)); }
template <class Epi, class Sched, bool ALIGN_EPI = false, bool SP2 = false>
__device__ __forceinline__ void gemm_phase(PG8_LAS unsigned char* lds, const Gemm g, const Sched& S, const Epi& E) {
    const int tid = threadIdx.x, wid = __builtin_amdgcn_readfirstlane(tid >> 6), lane = tid & 63, wr = wid >> 2, wc = wid & 3, fr = lane & 15, fq = lane >> 4;
    const int K = g.K, nt = K / BK;
    unsigned voffA[2], voffB[2];
#pragma unroll
    for (int i = 0; i < 2; ++i) { int R, C; stage_rc(tid * 16 + i * 8192, R, C); const int Rb = Epi::PERM ? ((R & ~31) + perm32(R & 31)) : R;
        voffA[i] = (unsigned)(R * K + C) * 2u; voffB[i] = (unsigned)(Rb * K + C) * 2u; }
    const size_t kstep = (size_t)(BK * 2);
    const size_t hstep = (size_t)HALF * K * 2;
    const size_t tstep = 2 * hstep;
    const unsigned ldsw = (unsigned)wid * 1024u;
    const int aoff = lds_byte(wr * 64 + fr, fq * 8), boff = lds_byte(wc * 32 + fr, fq * 8);
#define PG8_SA(b, h) (((b) * 2 + (h)) * HTB)
#define PG8_SB(b, h) ((4 + (b) * 2 + (h)) * HTB)
#define PG8_STAGE(bufoff, gbase, voff) do { _Pragma("unroll") for (int _i = 0; _i < 2; ++_i) \
        __builtin_amdgcn_global_load_lds((const unsigned*)((const char*)(gbase) + (voff)[_i]), (PG8_LAS unsigned*)(lds + (bufoff) + ldsw + _i * 8192), 16, 0, 0); } while (0)
#define PG8_LDA(dst, b, h) do { _Pragma("unroll") for (int m = 0; m < 4; ++m) _Pragma("unroll") for (int k = 0; k < 2; ++k) dst[m][k] = *(const PG8_LAS bf16x8*)(lds + PG8_SA(b, h) + aoff + m * 2048 + k * 1024); } while (0)
#define PG8_LDB(dst, b, h) do { _Pragma("unroll") for (int n = 0; n < 2; ++n) _Pragma("unroll") for (int k = 0; k < 2; ++k) dst[n][k] = *(const PG8_LAS bf16x8*)(lds + PG8_SB(b, h) + boff + n * 2048 + k * 1024); } while (0)
#define PG8_MMA(ai, bj, At, Bt) do { __builtin_amdgcn_s_setprio(1); _Pragma("unroll") for (int m = 0; m < 4; ++m) _Pragma("unroll") for (int n = 0; n < 2; ++n) _Pragma("unroll") for (int k = 0; k < 2; ++k) \
        acc[ai][bj][m][n] = __builtin_amdgcn_mfma_f32_16x16x32_bf16(Bt[n][k], At[m][k], acc[ai][bj][m][n], 0, 0, 0); __builtin_amdgcn_s_setprio(0); } while (0)
#define PG8_WAIT_V(n) asm volatile("s_waitcnt vmcnt(" #n ")" ::: "memory")
#define PG8_WAIT_L(n) asm volatile("s_waitcnt lgkmcnt(" #n ")" ::: "memory")
#define PG8_BAR __builtin_amdgcn_s_barrier()
#define PG8_SCHED __builtin_amdgcn_sched_barrier(0)
    Unit cur, nxt; int ui = 0;
    if (!S.next(0, cur)) return;
    f32x4 acc[2][2][4][2];
#pragma unroll
    for (int a = 0; a < 2; ++a)
#pragma unroll
        for (int b = 0; b < 2; ++b)
#pragma unroll
            for (int m = 0; m < 4; ++m)
#pragma unroll
                for (int n = 0; n < 2; ++n) acc[a][b][m][n] = (f32x4){0.f, 0.f, 0.f, 0.f};
    bf16x8 At[4][2], B0[2][2], B1[2][2];
    const char* cA = (const char*)g.A + (size_t)cur.pm * tstep; const char* cB = (const char*)g.Bt + (size_t)cur.pn * tstep;
    S.a_ready(cur);
    if constexpr (SP2) {
        PG8_STAGE(PG8_SB(0, 0), cB, voffB); PG8_STAGE(PG8_SB(0, 1), cB + hstep, voffB); PG8_STAGE(PG8_SA(0, 0), cA, voffA); PG8_STAGE(PG8_SA(0, 1), cA + hstep, voffA);
        if (wr == 1) PG8_BAR;
        PG8_WAIT_V(2); PG8_BAR;
        PG8_STAGE(PG8_SB(1, 0), cB + kstep, voffB); PG8_STAGE(PG8_SA(1, 0), cA + kstep, voffA); PG8_STAGE(PG8_SB(1, 1), cB + hstep + kstep, voffB);
        PG8_WAIT_V(6); PG8_BAR;
    } else {
        PG8_STAGE(PG8_SB(0, 0), cB, voffB); PG8_STAGE(PG8_SA(0, 0), cA, voffA); PG8_STAGE(PG8_SB(0, 1), cB + hstep, voffB); PG8_STAGE(PG8_SA(0, 1), cA + hstep, voffA);
        if (wr == 1) PG8_BAR;
        PG8_WAIT_V(4); PG8_BAR;
        PG8_STAGE(PG8_SB(1, 0), cB + kstep, voffB); PG8_STAGE(PG8_SA(1, 0), cA + kstep, voffA); PG8_STAGE(PG8_SB(1, 1), cB + hstep + kstep, voffB);
        PG8_WAIT_V(6); PG8_BAR;
    }
    for (;;) {
        const bool has_next = S.next(ui + 1, nxt);
        const char* nA = has_next ? (const char*)g.A + (size_t)nxt.pm * tstep : cA; const char* nB = has_next ? (const char*)g.Bt + (size_t)nxt.pn * tstep : cB;
        for (int t = 0; t < nt; t += 2) {
            const bool last = (t == nt - 2);
            const char* a1 = cA + (size_t)(t + 1) * kstep;
            const char* a2 = last ? nA : cA + (size_t)(t + 2) * kstep; const char* b2 = last ? nB : cB + (size_t)(t + 2) * kstep;
            const char* a3 = a2 + kstep; const char* b3 = b2 + kstep;
            if (last && has_next) S.a_ready(nxt);
            if constexpr (SP2) {
            PG8_LDB(B0, 0, 0); PG8_LDB(B1, 0, 1); PG8_SCHED; PG8_LDA(At, 0, 0); PG8_STAGE(PG8_SA(1, 1), a1 + hstep, voffA);
            PG8_WAIT_V(8); PG8_WAIT_L(0); PG8_BAR; PG8_MMA(0, 0, At, B0); PG8_MMA(0, 1, At, B1); PG8_BAR; PG8_SCHED;
            PG8_LDA(At, 0, 1); PG8_STAGE(PG8_SB(0, 0), b2, voffB); PG8_STAGE(PG8_SB(0, 1), b2 + hstep, voffB); PG8_STAGE(PG8_SA(0, 0), a2, voffA);
            PG8_WAIT_V(8); PG8_WAIT_L(0); PG8_BAR; PG8_MMA(1, 0, At, B0); PG8_MMA(1, 1, At, B1); PG8_BAR; PG8_SCHED;
            PG8_LDB(B0, 1, 0); PG8_LDB(B1, 1, 1); PG8_SCHED; PG8_LDA(At, 1, 0); PG8_STAGE(PG8_SA(0, 1), a2 + hstep, voffA);
            PG8_WAIT_V(8); PG8_WAIT_L(0); PG8_BAR; PG8_MMA(0, 0, At, B0); PG8_MMA(0, 1, At, B1); PG8_BAR; PG8_SCHED;
            PG8_LDA(At, 1, 1); PG8_STAGE(PG8_SB(1, 0), b3, voffB); PG8_STAGE(PG8_SB(1, 1), b3 + hstep, voffB); PG8_STAGE(PG8_SA(1, 0), a3, voffA);
            PG8_WAIT_V(8); PG8_WAIT_L(0); PG8_BAR; PG8_MMA(1, 0, At, B0); PG8_MMA(1, 1, At, B1); PG8_BAR; PG8_SCHED;
            } else {
            PG8_LDB(B0, 0, 0); PG8_SCHED; PG8_LDA(At, 0, 0); PG8_STAGE(PG8_SA(1, 1), a1 + hstep, voffA);
            PG8_WAIT_L(8); PG8_BAR; PG8_WAIT_L(0); PG8_MMA(0, 0, At, B0); PG8_BAR; PG8_SCHED;
            PG8_LDB(B1, 0, 1); PG8_STAGE(PG8_SB(0, 0), b2, voffB);
            PG8_BAR; PG8_WAIT_L(0); PG8_MMA(0, 1, At, B1); PG8_BAR;
            PG8_LDA(At, 0, 1); PG8_STAGE(PG8_SA(0, 0), a2, voffA);
            PG8_BAR; PG8_WAIT_L(0); PG8_MMA(1, 0, At, B0); PG8_BAR; PG8_SCHED;
            PG8_STAGE(PG8_SB(0, 1), b2 + hstep, voffB);
            PG8_WAIT_V(6); PG8_BAR; PG8_MMA(1, 1, At, B1); PG8_BAR;
            PG8_LDB(B0, 1, 0); PG8_SCHED; PG8_LDA(At, 1, 0); PG8_STAGE(PG8_SA(0, 1), a2 + hstep, voffA);
            PG8_WAIT_L(8); PG8_BAR; PG8_WAIT_L(0); PG8_MMA(0, 0, At, B0); PG8_BAR; PG8_SCHED;
            PG8_LDB(B1, 1, 1); PG8_STAGE(PG8_SB(1, 0), b3, voffB);
            PG8_BAR; PG8_WAIT_L(0); PG8_MMA(0, 1, At, B1); PG8_BAR;
            PG8_LDA(At, 1, 1); PG8_STAGE(PG8_SA(1, 0), a3, voffA);
            PG8_BAR; PG8_WAIT_L(0); PG8_MMA(1, 0, At, B0); PG8_BAR; PG8_SCHED;
            PG8_STAGE(PG8_SB(1, 1), b3 + hstep, voffB);
            PG8_WAIT_V(6); PG8_BAR; PG8_MMA(1, 1, At, B1); PG8_BAR;
            }
        }
        if constexpr (ALIGN_EPI) { if (wr == 0) PG8_BAR; }
        if constexpr (!Epi::AFTER_DRAIN) { E(acc, cur, wr, wc, fr, fq); S.done(cur); }
        if (!has_next) break;
#pragma unroll
        for (int a = 0; a < 2; ++a)
#pragma unroll
            for (int b = 0; b < 2; ++b)
#pragma unroll
                for (int m = 0; m < 4; ++m)
#pragma unroll
                    for (int n = 0; n < 2; ++n) acc[a][b][m][n] = (f32x4){0.f, 0.f, 0.f, 0.f};
        cur = nxt; cA = nA; cB = nB; ++ui;
        if constexpr (ALIGN_EPI) { if (wr == 1) PG8_BAR; }
    }
    PG8_WAIT_V(0);
    if constexpr (!ALIGN_EPI) { if (wr == 0) PG8_BAR; }
    PG8_BAR;
    if constexpr (Epi::AFTER_DRAIN) { E.fused(acc, cur, wr, wc, fr, fq, lds, wid, lane); S.done(cur); }
#undef PG8_SA
#undef PG8_SB
#undef PG8_STAGE
#undef PG8_LDA
#undef PG8_LDB
#undef PG8_MMA
#undef PG8_WAIT_V
#undef PG8_WAIT_L
#undef PG8_BAR
#undef PG8_SCHED
}
}
using pg8::bf16_t; using pg8::bf16x8; using pg8::f32x4; using pg8::u32x4; using pg8::Unit; using pg8::cvt_pk_bf16;
#define LAS __attribute__((address_space(3)))
typedef float f32x16 __attribute__((ext_vector_type(16)));
typedef unsigned u32x2 __attribute__((ext_vector_type(2)));
typedef short s16x4 __attribute__((ext_vector_type(4)));

#ifndef MK_USE_CG
#define MK_USE_CG 0
#endif
#ifndef MK_DUP
#define MK_DUP -1
#endif
#ifndef MK_LAUNCHES
#define MK_LAUNCHES 1
#endif
constexpr int NPHASE = 9;
constexpr int NTHREADS = 512, NWAVES = 8;
constexpr int LDS_BYTES = 147456;
constexpr int D = 1024, TP = 2048, NBP = 8, MP = NBP * TP  , NSQ = 128, TS = 4, MS = NSQ * TS  , M = MP + MS  ;
constexpr int WL = 1536, NBLK = 16, BW = 96;
constexpr int NH = 8, DK = 128, INNER = 1024;
constexpr float EPS = 1e-6f;
constexpr float LOG2E = 1.4426950408889634f;
constexpr size_t O_Y = 0, O_HP = 17301504, O_BP = 17313792, O_SP = 17350656, O_HS = 18399232, O_BS = 18595840, O_SS = 19185664;
constexpr size_t MiB = 1u << 20;
constexpr size_t WS_SS1 = 1 * MiB, WS_SS2 = WS_SS1 + 128 * 1024;
constexpr size_t WS_W1T = 2 * MiB, WS_W2T = 8 * MiB, WS_W3T = 11 * MiB, WS_W4T = 19 * MiB, WS_WRT = 21 * MiB, WS_LGS = 22 * MiB;
constexpr size_t WS_XA = 24 * MiB;
constexpr size_t WS_XB = 58 * MiB;
constexpr size_t WS_GS = WS_XB + (size_t)M * WL * 2;
constexpr size_t WS_Y = WS_GS + (size_t)M * WL * 2;
constexpr size_t WS_QB = 58 * MiB;
constexpr size_t WS_VB = 91 * MiB;
constexpr size_t WS_GB = 124 * MiB;
constexpr size_t WS_OPI = 157 * MiB;
constexpr size_t OPI_BYTES = 24576;
constexpr size_t WS_DV = 253 * MiB;
constexpr size_t WS_END = 256 * MiB;
static_assert(WS_OPI + 4096 * OPI_BYTES <= WS_DV, "ws map (operand images)");
static_assert(WS_GB - WS_VB == WS_VB - WS_QB && WS_Y + (size_t)M * WL * 2 <= 256 * MiB && WS_XA + (size_t)M * D * 2 <= WS_XB, "ws map");

struct Args { const float* in[20]; float* out; unsigned char* ws; int ph_lo, ph_hi; };

__device__ __forceinline__ float bf2f(unsigned short b) { return __builtin_bit_cast(float, (unsigned)b << 16); }
__device__ __forceinline__ float bflo(unsigned u) { return __builtin_bit_cast(float, u << 16); }
__device__ __forceinline__ float bfhi(unsigned u) { return __builtin_bit_cast(float, u & 0xffff0000u); }
typedef float f32x2_ __attribute__((ext_vector_type(2)));
typedef __bf16 bf16x2_ __attribute__((ext_vector_type(2)));
__device__ __forceinline__ unsigned pk2(float lo, float hi) { const f32x2_ v = {lo, hi}; return __builtin_bit_cast(unsigned, __builtin_convertvector(v, bf16x2_)); }
__device__ __forceinline__ unsigned f2bf(float f) { return pk2(f, f) & 0xffffu; }
__device__ __forceinline__ float ex2(float x) { return __builtin_amdgcn_exp2f(x); }
__device__ __forceinline__ float rcpf_(float x) { return __builtin_amdgcn_rcpf(x); }
__device__ __forceinline__ float sigmoidf_(float x) { return rcpf_(1.0f + ex2(-LOG2E * x)); }
__device__ __forceinline__ float siluf_(float x) { return x * sigmoidf_(x); }
__device__ __forceinline__ float wave_sum(float v) {
#pragma unroll
    for (int o = 1; o < 64; o <<= 1) v += __shfl_xor(v, o);
    return v;
}
#define LDS_WAIT() asm volatile("s_waitcnt lgkmcnt(0)" ::: "memory")
#define VM_WAIT() asm volatile("s_waitcnt vmcnt(0)" ::: "memory")

struct Epi1 {
    static constexpr bool PERM = true, AFTER_DRAIN = false;
    bf16_t* XB; bf16_t* GS; float* obp; float* obs;
    __device__ __forceinline__ void operator()(const f32x4 (&acc)[2][2][4][2], const Unit& u, int wr, int wc, int fr, int fq) const {
        const int row0 = u.pm * 256 + wr * 64 + fr; const bool isg = u.pn >= 6;
        const int colt = (isg ? u.pn - 6 : u.pn) * 256 + wc * 32 + 8 * fq; bf16_t* base = isg ? GS : XB;
#pragma unroll
        for (int ai = 0; ai < 2; ++ai)
#pragma unroll
            for (int m = 0; m < 4; ++m) { const int row = row0 + ai * 128 + m * 16;
                float* cb = nullptr;
                if (!isg) { if (row < MP) { const int t = row & (TP - 1); if (t >= TP - 3) cb = obp + ((size_t)((row >> 11) * 3 + (t - (TP - 3))) * WL); }
                            else { const int rs = row - MP, t = rs & 3; if (t >= 1) cb = obs + ((size_t)((rs >> 2) * 3 + (t - 1)) * WL); } }
#pragma unroll
                for (int bj = 0; bj < 2; ++bj) { f32x4 v0 = acc[ai][bj][m][0], v1 = acc[ai][bj][m][1]; const int col = colt + bj * 128;
                    if (isg) {
#pragma unroll
                        for (int j = 0; j < 4; ++j) { v0[j] = siluf_(v0[j]); v1[j] = siluf_(v1[j]); } }
                    else if (cb) { *(f32x4*)(cb + col) = v0; *(f32x4*)(cb + col + 4) = v1; }
                    u32x4 w; w.x = cvt_pk_bf16(v0[0], v0[1]); w.y = cvt_pk_bf16(v0[2], v0[3]); w.z = cvt_pk_bf16(v1[0], v1[1]); w.w = cvt_pk_bf16(v1[2], v1[3]);
                    *(u32x4*)(base + (size_t)row * WL + col) = w; } }
    }
};
struct Epi2 {
    static constexpr bool PERM = true, AFTER_DRAIN = false;
    const float* xp; const float* xs; float* X1; bf16_t* X1B; float* ss;
    __device__ __forceinline__ void operator()(const f32x4 (&acc)[2][2][4][2], const Unit& u, int wr, int wc, int fr, int fq) const {
        const int row0 = u.pm * 256 + wr * 64 + fr, colt = u.pn * 256 + wc * 32 + 8 * fq;
#pragma unroll
        for (int ai = 0; ai < 2; ++ai)
#pragma unroll
            for (int m = 0; m < 4; ++m) { const int row = row0 + ai * 128 + m * 16;
                const float* xin = row < MP ? xp + (size_t)row * D : xs + (size_t)(row - MP) * D; float sq = 0.f;
#pragma unroll
                for (int bj = 0; bj < 2; ++bj) { const int col = colt + bj * 128;
                    f32x4 v0 = acc[ai][bj][m][0] + *(const f32x4*)(xin + col), v1 = acc[ai][bj][m][1] + *(const f32x4*)(xin + col + 4);
                    sq += (v0[0] * v0[0] + v0[1] * v0[1]) + (v0[2] * v0[2] + v0[3] * v0[3]) + (v1[0] * v1[0] + v1[1] * v1[1]) + (v1[2] * v1[2] + v1[3] * v1[3]);
                    u32x4 w; w.x = cvt_pk_bf16(v0[0], v0[1]); w.y = cvt_pk_bf16(v0[2], v0[3]); w.z = cvt_pk_bf16(v1[0], v1[1]); w.w = cvt_pk_bf16(v1[2], v1[3]);
                    *(u32x4*)(X1B + (size_t)row * D + col) = w; }
                sq += __shfl_xor(sq, 16); sq += __shfl_xor(sq, 32);
                if (fq == 0) atomicAdd(ss + row, sq); }
    }
};
__device__ __forceinline__ f32x4 lbvec(const float* l0) { const f32x4 a = *(const f32x4*)l0, c = *(const f32x4*)(l0 + D); return (f32x4){sigmoidf_(c[0] - a[0]), sigmoidf_(c[1] - a[1]), sigmoidf_(c[2] - a[2]), sigmoidf_(c[3] - a[3])}; }
struct Epi3 {
    static constexpr bool PERM = true, AFTER_DRAIN = false;
    const float* ss1; const float* lbl; bf16_t* QB; bf16_t* VB; bf16_t* GB; float* LGp; float* LGs;
    __device__ __forceinline__ void operator()(const f32x4 (&acc)[2][2][4][2], const Unit& u, int wr, int wc, int fr, int fq) const {
        const int row0 = u.pm * 256 + wr * 64 + fr, sec = u.pn >> 2, colt = (u.pn & 3) * 256 + wc * 32 + 8 * fq;
        const f32x4 lbA0 = lbvec(lbl + colt), lbA1 = lbvec(lbl + colt + 4), lbB0 = lbvec(lbl + colt + 128), lbB1 = lbvec(lbl + colt + 132);
        bf16_t* ob = QB + (size_t)(sec == 0 ? 0 : sec - 1) * ((WS_VB - WS_QB) / 2);
#pragma unroll
        for (int ai = 0; ai < 2; ++ai)
#pragma unroll
            for (int m = 0; m < 4; ++m) { const int row = row0 + ai * 128 + m * 16;
                const float rstd = __builtin_amdgcn_rsqf(ss1[row] * (1.0f / D) + EPS);
#pragma unroll
                for (int bj = 0; bj < 2; ++bj) { f32x4 v0 = acc[ai][bj][m][0] * rstd, v1 = acc[ai][bj][m][1] * rstd; const int col = colt + bj * 128;
                    if (sec == 1) { const f32x4 l0v = bj ? lbB0 : lbA0, l1v = bj ? lbB1 : lbA1;
#pragma unroll
                        for (int j = 0; j < 4; ++j) { v0[j] = __builtin_amdgcn_logf(l0v[j] + (1.0f - l0v[j]) * sigmoidf_(v0[j])); v1[j] = __builtin_amdgcn_logf(l1v[j] + (1.0f - l1v[j]) * sigmoidf_(v1[j])); }
                        float* lp = (row < MP ? LGp + (size_t)row * INNER : LGs + (size_t)(row - MP) * INNER) + col;
                        *(f32x4*)lp = v0; *(f32x4*)(lp + 4) = v1;
                    } else {
                        if (sec != 2) {
#pragma unroll
                            for (int j = 0; j < 4; ++j) { v0[j] = siluf_(v0[j]); v1[j] = siluf_(v1[j]); } }
                        u32x4 w; w.x = cvt_pk_bf16(v0[0], v0[1]); w.y = cvt_pk_bf16(v0[2], v0[3]); w.z = cvt_pk_bf16(v1[0], v1[1]); w.w = cvt_pk_bf16(v1[2], v1[3]);
                        *(u32x4*)(ob + (size_t)row * INNER + col) = w; } } }
    }
};
struct OneUnit { int pm, pn;
    __device__ __forceinline__ bool next(int i, Unit& u) const { if (i > 0) return false; u.pm = pm; u.pn = pn; return true; }
    __device__ __forceinline__ void a_ready(const Unit&) const {}
    __device__ __forceinline__ void done(const Unit&) const {} };
struct Epi4 {
    static constexpr bool PERM = true, AFTER_DRAIN = false;
    const bf16_t* X1B; float* ss; float* XO;
    __device__ __forceinline__ void operator()(const f32x4 (&acc)[2][2][4][2], const Unit& u, int wr, int wc, int fr, int fq) const {
        const int row0 = u.pm * 256 + wr * 64 + fr, colt = u.pn * 256 + wc * 32 + 8 * fq;
#pragma unroll
        for (int ai = 0; ai < 2; ++ai)
#pragma unroll
            for (int m = 0; m < 4; ++m) { const int row = row0 + ai * 128 + m * 16; float sq = 0.f;
#pragma unroll
                for (int bj = 0; bj < 2; ++bj) { const size_t e = (size_t)row * D + colt + bj * 128; const u32x4 xb = *(const u32x4*)(X1B + e);
                    f32x4 v0 = acc[ai][bj][m][0] + (f32x4){bflo(xb.x), bfhi(xb.x), bflo(xb.y), bfhi(xb.y)}, v1 = acc[ai][bj][m][1] + (f32x4){bflo(xb.z), bfhi(xb.z), bflo(xb.w), bfhi(xb.w)};
                    *(f32x4*)(XO + e) = v0; *(f32x4*)(XO + e + 4) = v1;
                    sq += (v0[0] * v0[0] + v0[1] * v0[1]) + (v0[2] * v0[2] + v0[3] * v0[3]) + (v1[0] * v1[0] + v1[1] * v1[1]) + (v1[2] * v1[2] + v1[3] * v1[3]); }
                sq += __shfl_xor(sq, 16); sq += __shfl_xor(sq, 32);
                if (fq == 0) atomicAdd(ss + row, sq); }
    }
};
template <int MODE>
__device__ __forceinline__ void small_gemm_sample(const bf16_t* A, const bf16_t* Bt, int K, const float* xs, float* X, const bf16_t* X1Bc, float* ss) { bf16_t* X1B = const_cast<bf16_t*>(X1Bc);
    const int tid = threadIdx.x, lane = tid & 63, wave = __builtin_amdgcn_readfirstlane(tid >> 6), fr = lane & 15, fq = lane >> 4;
    for (int tile = blockIdx.x; tile < 256; tile += gridDim.x) {
        const int r0 = (tile >> 4) * 32 + (wave >> 2) * 16, n0 = (tile & 15) * 64 + (wave & 3) * 16;
        const bf16_t* ap = A + (size_t)(MP + r0 + fr) * K + fq * 8; const bf16_t* bp = Bt + (size_t)(n0 + fr) * K + fq * 8;
        f32x4 acc0 = {0.f, 0.f, 0.f, 0.f}, acc1 = {0.f, 0.f, 0.f, 0.f};
        for (int k0 = 0; k0 < K; k0 += 256) {
            bf16x8 af[8], bfv[8];
#pragma unroll
            for (int u = 0; u < 8; ++u) { af[u] = *(const bf16x8*)(ap + k0 + 32 * u); bfv[u] = *(const bf16x8*)(bp + k0 + 32 * u); }
#pragma unroll
            for (int u = 0; u < 8; u += 2) { acc0 = __builtin_amdgcn_mfma_f32_16x16x32_bf16(bfv[u], af[u], acc0, 0, 0, 0); acc1 = __builtin_amdgcn_mfma_f32_16x16x32_bf16(bfv[u + 1], af[u + 1], acc1, 0, 0, 0); }
        }
        const f32x4 acc = acc0 + acc1;
        const int row = MP + r0 + fr, col = n0 + 4 * fq; const size_t e = (size_t)row * D + col;
        f32x4 v;
        if (MODE == 0) { v = acc + *(const f32x4*)(xs + (size_t)(r0 + fr) * D + col); u32x2 w; w.x = pk2(v[0], v[1]); w.y = pk2(v[2], v[3]); *(u32x2*)(X1B + e) = w; }
        else { const u32x2 xb = *(const u32x2*)(X1B + e); v = acc + (f32x4){bflo(xb.x), bfhi(xb.x), bflo(xb.y), bfhi(xb.y)}; *(f32x4*)(X + e) = v; }
        float sq = (v[0] * v[0] + v[1] * v[1]) + (v[2] * v[2] + v[3] * v[3]);
        sq += __shfl_xor(sq, 16); sq += __shfl_xor(sq, 32);
        if (fq == 0) atomicAdd(ss + row, sq);
    }
}

__device__ __forceinline__ void p0_transpose_item(const float* W, int K, int N, const float* gain, bf16_t* WT, LAS float* scr, int item, int lane) {
    const int nblk = N / 32, kb = item / nblk, nb = item % nblk, k0 = 64 * kb, n0 = 32 * nb;
    float wv[32];
#pragma unroll
    for (int i = 0; i < 32; ++i) { const int kk = 2 * i + (lane >> 5); wv[i] = W[(size_t)(k0 + kk) * N + n0 + (lane & 31)]; }
#pragma unroll
    for (int i = 0; i < 32; ++i) { const int kk = 2 * i + (lane >> 5); const float gk = gain ? gain[k0 + kk] : 1.0f; scr[kk * 33 + (lane & 31)] = wv[i] * gk; }
    LDS_WAIT(); asm volatile("" ::: "memory");
    const int c = lane & 7;
#pragma unroll
    for (int j = 0; j < 4; ++j) { const int n = (lane >> 3) + 8 * j; const LAS float* s = scr + (8 * c) * 33 + n;
        u32x4 o; o.x = pk2(s[0 * 33], s[1 * 33]); o.y = pk2(s[2 * 33], s[3 * 33]); o.z = pk2(s[4 * 33], s[5 * 33]); o.w = pk2(s[6 * 33], s[7 * 33]);
        *(u32x4*)(WT + (size_t)(n0 + n) * K + k0 + 8 * c) = o; }
    LDS_WAIT(); asm volatile("" ::: "memory");
}
__device__ __forceinline__ void p0_prologue(const Args& a, LAS unsigned char* lds) {
    const int tid = threadIdx.x, lane = tid & 63, wave = tid >> 6, G = gridDim.x;
    LAS float* scr = (LAS float*)(lds + wave * 16384);
    const int gw = blockIdx.x * NWAVES + wave, NGW = G * NWAVES;
    unsigned char* ws = a.ws;
    constexpr int I1 = (D / 64) * (2 * WL / 32);
    for (int it = gw; it < I1; it += NGW) p0_transpose_item(a.in[6], D, 2 * WL, a.in[5], (bf16_t*)(ws + WS_W1T), scr, it, lane);
    { bf16_t* wrt = (bf16_t*)(ws + WS_WRT); const int gt = blockIdx.x * NTHREADS + tid, NT = G * NTHREADS;
      for (int o = gt; o < 2 * NBLK * BW * BW; o += NT) { const int which = o / (NBLK * BW * BW), r = o % (NBLK * BW * BW), n = r / (BW * BW), j = (r / BW) % BW, i = r % BW;
          wrt[o] = (bf16_t)f2bf((which ? a.in[11] : a.in[9])[(n * BW + i) * BW + j]); }
      float* ss1 = (float*)(ws + WS_SS1); float* ss2 = (float*)(ws + WS_SS2);
      for (int o = gt; o < M; o += NT) { ss1[o] = 0.f; ss2[o] = 0.f; } }
    bf16_t* XA = (bf16_t*)(ws + WS_XA);
    for (int m = gw; m < M; m += NGW) {
        const float* xrow = m < MP ? a.in[0] + (size_t)m * D : a.in[1] + (size_t)(m - MP) * D;
        const f32x4* xr = (const f32x4*)xrow + lane; f32x4 v[4]; float s = 0.f;
#pragma unroll
        for (int j = 0; j < 4; ++j) { v[j] = xr[64 * j]; s += (v[j].x * v[j].x + v[j].y * v[j].y) + (v[j].z * v[j].z + v[j].w * v[j].w); }
        const float rstd = __builtin_amdgcn_rsqf(wave_sum(s) * (1.f / D) + EPS);
        unsigned long long* o8 = (unsigned long long*)(XA + (size_t)m * D) + lane;
#pragma unroll
        for (int j = 0; j < 4; ++j) o8[64 * j] = (unsigned long long)pk2(v[j].x * rstd, v[j].y * rstd) | ((unsigned long long)pk2(v[j].z * rstd, v[j].w * rstd) << 32);
    }
}

__device__ __forceinline__ void p0_late_weights(const Args& a, LAS unsigned char* lds, int rank, int count) {
    const int tid = threadIdx.x, lane = tid & 63, wave = tid >> 6;
    LAS float* scr = (LAS float*)(lds + wave * 16384);
    const int gw = rank * NWAVES + wave, NGW = count * NWAVES; unsigned char* ws = a.ws;
    constexpr int I2 = (WL / 64) * (D / 32), I3 = (D / 64) * (4 * INNER / 32), I4 = (INNER / 64) * (D / 32);
    for (int it = gw; it < I2 + I3 + I4; it += NGW) {
        int r = it;
        if (r < I2) { p0_transpose_item(a.in[14], WL, D, nullptr, (bf16_t*)(ws + WS_W2T), scr, r, lane); continue; } r -= I2;
        if (r < I3) { p0_transpose_item(a.in[15], D, 4 * INNER, a.in[5] + D, (bf16_t*)(ws + WS_W3T), scr, r, lane); continue; } r -= I3;
        p0_transpose_item(a.in[18], INNER, D, nullptr, (bf16_t*)(ws + WS_W4T), scr, r, lane);
    }
}

constexpr int P2_RAW = 0, P2_XC = 25600, P2_WT = 52224, P2_AB = 72192, P2_AGG = 121344, P2_PRM = 124416;
__device__ __forceinline__ void p2_lru(const Args& a, LAS unsigned char* lds) {
    const int tid = threadIdx.x, lane = tid & 63, wave = __builtin_amdgcn_readfirstlane(tid >> 6), fr = lane & 15, fq = lane >> 4;
    unsigned char* ws = a.ws;
    const bf16_t* XB = (const bf16_t*)(ws + WS_XB); const bf16_t* GS = (const bf16_t*)(ws + WS_GS); bf16_t* Y = (bf16_t*)(ws + WS_Y);
    const bf16_t* WRT = (const bf16_t*)(ws + WS_WRT);
    LAS float* prm = (LAS float*)(lds + P2_PRM);
    for (int item = blockIdx.x; item < 384; item += gridDim.x) {
        const bool smp = item >= 256;
        int n, half, nch, chunk0, row_base, b = 0;
        if (!smp) { b = item >> 5; n = (item >> 1) & 15; half = item & 1; nch = 16; chunk0 = 0; row_base = b * TP; }
        else { const int it = item - 256; n = it >> 3; half = (it >> 2) & 1; nch = 1; chunk0 = it & 3; row_base = MP; }
        const int ch0 = n * BW, oc0 = ch0 + half * 48;
        __syncthreads();
        for (int p = tid; p < 96 * 12; p += NTHREADS) { const int r = p / 12, cp = p % 12, which = r / 48, j = half * 48 + (r % 48);
            *(LAS u32x4*)(lds + P2_WT + r * 208 + cp * 16) = *(const u32x4*)(WRT + ((size_t)(which * NBLK + n) * BW + j) * BW + cp * 8); }
        const int rg = tid >> 4, cq = tid & 15;
        float cw0[6], cw1[6], cw2[6], cw3[6], cvb[6];
#pragma unroll
        for (int c = 0; c < 6; ++c) { const int ch = ch0 + 6 * cq + c; cw0[c] = a.in[7][ch]; cw1[c] = a.in[7][WL + ch]; cw2[c] = a.in[7][2 * WL + ch]; cw3[c] = a.in[7][3 * WL + ch]; cvb[c] = a.in[8][ch]; }
        if (tid < 48) { prm[480 + tid] = a.in[10][oc0 + tid]; prm[528 + tid] = a.in[12][oc0 + tid];
            const float lam = a.in[13][oc0 + tid]; const float sp = (lam > 15.f) ? __expf(-lam) : log1pf(__expf(-lam));
            prm[576 + tid] = -8.0f * sp * LOG2E; }
        float carry = 0.f;
        const int sr = tid / 12, scp = tid % 12;
        u32x4 pre[3], hal = {0u, 0u, 0u, 0u};
        { const int r0 = row_base + chunk0 * 128;
#pragma unroll
          for (int i = 0; i < 3; ++i) { const int p = tid + i * NTHREADS, r = p / 12, cp = p % 12; pre[i] = *(const u32x4*)(XB + (size_t)(r0 + r) * WL + ch0 + cp * 8); } }
        for (int ci = 0; ci < nch; ++ci) {
            const int chunk = chunk0 + ci, r0 = row_base + chunk * 128, rw = r0 + 16 * wave;
#pragma unroll
            for (int i = 0; i < 3; ++i) { const int p = tid + i * NTHREADS, r = p / 12, cp = p % 12; *(LAS u32x4*)(lds + P2_RAW + (r + 3) * 192 + cp * 16) = pre[i]; }
            if (tid < 36) *(LAS u32x4*)(lds + P2_RAW + sr * 192 + scp * 16) = hal;
            const int pt0 = lane / 6, pc0 = lane % 6, pt1 = (lane + 64) / 6, pc1 = (lane + 64) % 6;
            const u32x4 gs0 = *(const u32x4*)(GS + (size_t)(rw + pt0) * WL + oc0 + pc0 * 8);
            u32x4 gs1 = {0u, 0u, 0u, 0u}; if (lane < 32) gs1 = *(const u32x4*)(GS + (size_t)(rw + pt1) * WL + oc0 + pc1 * 8);
            if (ci + 1 < nch) {
#pragma unroll
                for (int i = 0; i < 3; ++i) { const int p = tid + i * NTHREADS, r = p / 12, cp = p % 12; pre[i] = *(const u32x4*)(XB + (size_t)(r0 + 128 + r) * WL + ch0 + cp * 8); }
                if (tid < 36) hal = *(const u32x4*)(XB + (size_t)(r0 + 125 + sr) * WL + ch0 + scp * 8); }
            __syncthreads();
            { float win[7][6];
#pragma unroll
              for (int r = 0; r < 7; ++r) {
                  if (smp && r < 3) { const float* bp = a.in[3] + ((size_t)((chunk * 32 + rg) * 3 + r) * WL + ch0 + 6 * cq);
#pragma unroll
                      for (int c = 0; c < 3; ++c) { const f32x2_ x = *(const f32x2_*)(bp + 2 * c); win[r][2 * c] = x[0]; win[r][2 * c + 1] = x[1]; } }
                  else {
#pragma unroll
                      for (int c = 0; c < 3; ++c) { const unsigned x = *(const LAS unsigned*)(lds + P2_RAW + (4 * rg + r) * 192 + cq * 12 + c * 4); win[r][2 * c] = bflo(x); win[r][2 * c + 1] = bfhi(x); } } }
#pragma unroll
              for (int r = 0; r < 4; ++r) { float o[6];
#pragma unroll
                  for (int c = 0; c < 6; ++c) o[c] = cvb[c] + cw0[c] * win[r][c] + cw1[c] * win[r + 1][c] + cw2[c] * win[r + 2][c] + cw3[c] * win[r + 3][c];
#pragma unroll
                  for (int c = 0; c < 3; ++c) *(LAS unsigned*)(lds + P2_XC + (4 * rg + r) * 208 + cq * 12 + c * 4) = pk2(o[2 * c], o[2 * c + 1]); } }
            __syncthreads();
            f32x4 acc[6];
#pragma unroll
            for (int nt = 0; nt < 6; ++nt) acc[nt] = (f32x4){0.f, 0.f, 0.f, 0.f};
#pragma unroll
            for (int kk = 0; kk < 3; ++kk) { const bf16x8 af = *(const LAS bf16x8*)(lds + P2_XC + (16 * wave + fr) * 208 + kk * 64 + fq * 16);
#pragma unroll
                for (int nt = 0; nt < 6; ++nt) { const bf16x8 bfr = *(const LAS bf16x8*)(lds + P2_WT + (nt * 16 + fr) * 208 + kk * 64 + fq * 16);
                    acc[nt] = __builtin_amdgcn_mfma_f32_16x16x32_bf16(bfr, af, acc[nt], 0, 0, 0); } }
            LAS float* abw = (LAS float*)(lds + P2_AB + wave * 6144);
#pragma unroll
            for (int nt = 0; nt < 3; ++nt) { const int cl = nt * 16 + 4 * fq;
                const u32x2 xq = *(const LAS u32x2*)(lds + P2_XC + (16 * wave + fr) * 208 + (half * 48 + cl) * 2);
                const float xc[4] = {bflo(xq.x), bfhi(xq.x), bflo(xq.y), bfhi(xq.y)}; f32x4 av, bv;
#pragma unroll
                for (int j = 0; j < 4; ++j) { const float r = sigmoidf_(acc[nt][j] + prm[480 + cl + j]), ig = sigmoidf_(acc[nt + 3][j] + prm[528 + cl + j]);
                    const float la = prm[576 + cl + j] * r, aa = ex2(la), om = 1.0f - aa * aa;
                    av[j] = aa; bv[j] = __builtin_amdgcn_sqrtf(fmaxf(om, 0.f)) * (ig * xc[j]); }
                *(LAS f32x4*)(abw + fr * 48 + cl) = av; *(LAS f32x4*)(abw + 768 + fr * 48 + cl) = bv; }
            LDS_WAIT(); asm volatile("" ::: "memory");
            const int cl = lane < 48 ? lane : 47;
            LAS float* agg = (LAS float*)(lds + P2_AGG);
            if (!smp) {
                float hloc[16], acum[16]; float Ac = 1.f, Bl = 0.f;
#pragma unroll
                for (int t = 0; t < 16; ++t) { const float at = abw[t * 48 + cl], bt = abw[768 + t * 48 + cl]; Bl = at * Bl + bt; Ac *= at; hloc[t] = Bl; acum[t] = Ac; }
                if (lane < 48) { agg[(wave * 2) * 48 + lane] = Ac; agg[(wave * 2 + 1) * 48 + lane] = Bl; }
                __syncthreads();
                float h = carry, hin = 0.f;
#pragma unroll
                for (int w = 0; w < 8; ++w) { if (w == wave) hin = h; h = agg[(w * 2) * 48 + cl] * h + agg[(w * 2 + 1) * 48 + cl]; }
                carry = h;
                if (lane < 48) {
#pragma unroll
                    for (int t = 0; t < 16; ++t) { const float hv = hloc[t] + acum[t] * hin; abw[768 + t * 48 + lane] = hv;
                        if (t == 15 && chunk == 15 && wave == 7) a.out[O_HP + (size_t)b * WL + oc0 + lane] = hv; } }
            } else {
                __syncthreads();
                float h = 0.f;
#pragma unroll
                for (int t = 0; t < 16; ++t) { const int sq = (chunk * 128 + 16 * wave + t) >> 2;
                    if ((t & 3) == 0) h = a.in[2][(size_t)sq * WL + oc0 + cl];
                    h = abw[t * 48 + cl] * h + abw[768 + t * 48 + cl];
                    if (lane < 48) { abw[768 + t * 48 + lane] = h; if ((t & 3) == 3) a.out[O_HS + (size_t)sq * WL + oc0 + lane] = h; } }
            }
            LDS_WAIT(); asm volatile("" ::: "memory");
            { const LAS float* hp = abw + 768 + pt0 * 48 + pc0 * 8; const f32x4 h0 = *(const LAS f32x4*)hp, h1 = *(const LAS f32x4*)(hp + 4);
              u32x4 w; w.x = pk2(h0[0] * bflo(gs0.x), h0[1] * bfhi(gs0.x)); w.y = pk2(h0[2] * bflo(gs0.y), h0[3] * bfhi(gs0.y)); w.z = pk2(h1[0] * bflo(gs0.z), h1[1] * bfhi(gs0.z)); w.w = pk2(h1[2] * bflo(gs0.w), h1[3] * bfhi(gs0.w));
              *(u32x4*)(Y + (size_t)(rw + pt0) * WL + oc0 + pc0 * 8) = w; }
            if (lane < 32) { const LAS float* hp = abw + 768 + pt1 * 48 + pc1 * 8; const f32x4 h0 = *(const LAS f32x4*)hp, h1 = *(const LAS f32x4*)(hp + 4);
              u32x4 w; w.x = pk2(h0[0] * bflo(gs1.x), h0[1] * bfhi(gs1.x)); w.y = pk2(h0[2] * bflo(gs1.y), h0[3] * bfhi(gs1.y)); w.z = pk2(h1[0] * bflo(gs1.z), h1[1] * bfhi(gs1.z)); w.w = pk2(h1[2] * bflo(gs1.w), h1[3] * bfhi(gs1.w));
              *(u32x4*)(Y + (size_t)(rw + pt1) * WL + oc0 + pc1 * 8) = w; }
        }
    }
}

constexpr int E1_QT = 0, E1_KT = 8704, E1_VT = 17408, E1_PL = 27648, E1_GT = 30208, E1_QE = 32256;
__device__ __forceinline__ void p5a_prep(const Args& a, LAS unsigned char* lds) {
    const int tid = threadIdx.x, lane = tid & 63, wave = __builtin_amdgcn_readfirstlane(tid >> 6), fr = lane & 15, fq = lane >> 4;
    const int k = tid & 127, tg = tid >> 7;
    unsigned char* ws = a.ws;
    const bf16_t* QB = (const bf16_t*)(ws + WS_QB); const bf16_t* VB = (const bf16_t*)(ws + WS_VB); const float* LG = a.out + O_SS;
    bf16_t* INTRA = (bf16_t*)(a.out + O_Y); unsigned char* OPI = ws + WS_OPI; float* DV = (float*)(ws + WS_DV);
    const int qoff = (((k >> 5) * 2 + ((k >> 4) & 1)) * 64 + 32 * ((k >> 2) & 1)) * 16 + ((k & 3) + 4 * ((k >> 3) & 1)) * 2;
    const int koff = ((8 + (k >> 5) * 2 + (tg >> 1)) * 64 + (k & 31) + 32 * (tg & 1)) * 16;
    LAS float* gt = (LAS float*)(lds + E1_GT);
    float lgn[8]; unsigned short qn[8], vn[8];
    if (blockIdx.x < 4096) { const int item = blockIdx.x, b = item >> 9, h = (item >> 6) & 7, c = item & 63; const size_t e0 = ((size_t)b * TP + c * 32 + 8 * tg) * INNER + h * DK + k;
#pragma unroll
        for (int i = 0; i < 8; ++i) { lgn[i] = LG[e0 + (size_t)i * INNER]; qn[i] = QB[e0 + (size_t)i * INNER]; vn[i] = VB[e0 + (size_t)i * INNER]; } }
    for (int item = blockIdx.x; item < 4096; item += gridDim.x) {
        const int b = item >> 9, h = (item >> 6) & 7, c = item & 63;
        const size_t rowb = (size_t)b * TP + c * 32, e0 = (rowb + 8 * tg) * INNER + h * DK + k;
        unsigned char* img = OPI + (size_t)item * OPI_BYTES;
        float lg[8], q[8]; unsigned short vv[8];
#pragma unroll
        for (int i = 0; i < 8; ++i) { lg[i] = lgn[i]; q[i] = bf2f(qn[i]); vv[i] = vn[i]; }
        float cs[8]; float run = 0.f;
#pragma unroll
        for (int i = 0; i < 8; ++i) { run += lg[i]; cs[i] = run; }
        gt[tg * 128 + k] = run;
        u32x4 vp; vp.x = vv[0] | ((unsigned)vv[1] << 16); vp.y = vv[2] | ((unsigned)vv[3] << 16); vp.z = vv[4] | ((unsigned)vv[5] << 16); vp.w = vv[6] | ((unsigned)vv[7] << 16);
        *(LAS u32x4*)(lds + E1_VT + k * 80 + tg * 16) = vp;
        __syncthreads();
        { const int nitem = item + gridDim.x;
          if (nitem < 4096) { const int nb = nitem >> 9, nh = (nitem >> 6) & 7, nc = nitem & 63; const size_t ne0 = ((size_t)nb * TP + nc * 32 + 8 * tg) * INNER + nh * DK + k;
#pragma unroll
              for (int i = 0; i < 8; ++i) { lgn[i] = LG[ne0 + (size_t)i * INNER]; qn[i] = QB[ne0 + (size_t)i * INNER]; vn[i] = VB[ne0 + (size_t)i * INNER]; } } }
        const float g0 = gt[k], g1 = gt[128 + k], g2 = gt[256 + k], g3 = gt[384 + k];
        const float off = (tg > 0 ? g0 : 0.f) + (tg > 1 ? g1 : 0.f) + (tg > 2 ? g2 : 0.f), tot = (g0 + g1) + (g2 + g3), mid = g0 + g1;
        unsigned short kep[8];
#pragma unroll
        for (int i = 0; i < 8; ++i) { const float cum = off + cs[i], kk = 1.0f - ex2(lg[i]);
            const float qt = q[i] * ex2(fminf(cum - mid, 115.f)), kt = kk * ex2(fminf(mid - cum, 115.f));
            *(LAS unsigned short*)(lds + E1_QT + (8 * tg + i) * 272 + k * 2) = (unsigned short)f2bf(qt);
            *(LAS unsigned short*)(lds + E1_KT + (8 * tg + i) * 272 + k * 2) = (unsigned short)f2bf(kt);
            *(LAS unsigned short*)(lds + E1_QE + (8 * tg + i) * 272 + k * 2) = (unsigned short)f2bf(q[i] * ex2(cum));
            kep[i] = (unsigned short)f2bf(kk * ex2(tot - cum)); }
        u32x4 kp; kp.x = kep[0] | ((unsigned)kep[1] << 16); kp.y = kep[2] | ((unsigned)kep[3] << 16); kp.z = kep[4] | ((unsigned)kep[5] << 16); kp.w = kep[6] | ((unsigned)kep[7] << 16);
        *(u32x4*)(img + koff) = kp;
        *(u32x4*)(img + koff + 8 * 1024) = vp;
        if (tg == 0) DV[(size_t)item * 128 + k] = ex2(tot);
        __syncthreads();
        { const int f = tid >> 6, tq = lane & 31, gq = lane >> 5;
          const LAS unsigned char* qr = lds + E1_QE + tq * 272 + (f * 16 + 4 * gq) * 2;
          const u32x2 lo = *(const LAS u32x2*)qr, hi = *(const LAS u32x2*)(qr + 16);
          *(u32x4*)(img + tid * 16) = (u32x4){lo.x, lo.y, hi.x, hi.y}; }
        if (wave < 3) { const int mt = wave > 0 ? 1 : 0, st = wave > 1 ? 1 : 0; f32x4 acc = {0.f, 0.f, 0.f, 0.f};
#pragma unroll
            for (int ks = 0; ks < 4; ++ks) { const bf16x8 kf = *(const LAS bf16x8*)(lds + E1_KT + (16 * st + fr) * 272 + ks * 64 + fq * 16), qf = *(const LAS bf16x8*)(lds + E1_QT + (16 * mt + fr) * 272 + ks * 64 + fq * 16);
                acc = __builtin_amdgcn_mfma_f32_16x16x32_bf16(kf, qf, acc, 0, 0, 0); }
            const int t = 16 * mt + fr, s0 = 16 * st + 4 * fq;
            u32x2 w; w.x = pk2(s0 <= t ? acc[0] : 0.f, s0 + 1 <= t ? acc[1] : 0.f); w.y = pk2(s0 + 2 <= t ? acc[2] : 0.f, s0 + 3 <= t ? acc[3] : 0.f);
            *(LAS u32x2*)(lds + E1_PL + t * 80 + s0 * 2) = w;
        } else if (wave == 3) { *(LAS u32x2*)(lds + E1_PL + fr * 80 + (16 + 4 * fq) * 2) = (u32x2){0u, 0u}; }
        __syncthreads();
        { const bf16x8 vf = *(const LAS bf16x8*)(lds + E1_VT + (16 * wave + fr) * 80 + fq * 16);
#pragma unroll
          for (int mt = 0; mt < 2; ++mt) { const bf16x8 pf = *(const LAS bf16x8*)(lds + E1_PL + (16 * mt + fr) * 80 + fq * 16);
              const f32x4 o = __builtin_amdgcn_mfma_f32_16x16x32_bf16(vf, pf, (f32x4){0.f, 0.f, 0.f, 0.f}, 0, 0, 0);
              u32x2 w; w.x = pk2(o[0], o[1]); w.y = pk2(o[2], o[3]);
              *(u32x2*)(INTRA + (rowb + 16 * mt + fr) * INNER + h * DK + 16 * wave + 4 * fq) = w; } }
    }
}

struct Pre6 { u32x4 a[2]; u32x4 v; u32x4 d; };
constexpr int R6_SLOT = 18944;
__device__ __forceinline__ void p6_load(Pre6& f, const unsigned char* OPI, const float* DV, int item, int vt, int tid) {
    const unsigned char* img = OPI + (size_t)item * OPI_BYTES;
    f.a[0] = *(const u32x4*)(img + tid * 16); f.a[1] = *(const u32x4*)(img + (tid + NTHREADS) * 16);
    if (tid < 128) f.v = *(const u32x4*)(img + (16 * 64 + vt * 128 + tid) * 16);
    if (tid < 32) f.d = *(const u32x4*)(DV + (size_t)item * 128 + tid * 4);
}
__device__ __forceinline__ void p6_stage(const Pre6& f, LAS unsigned char* slot, int tid) {
    *(LAS u32x4*)(slot + tid * 16) = f.a[0]; *(LAS u32x4*)(slot + (tid + NTHREADS) * 16) = f.a[1];
    if (tid < 128) *(LAS u32x4*)(slot + 16384 + tid * 16) = f.v;
    if (tid < 32) *(LAS u32x4*)(slot + 18432 + tid * 16) = f.d;
}
__device__ __forceinline__ void p6_step(const LAS unsigned char* slot, f32x16& S, LAS float* OP, bf16_t* INTER, int c, size_t eoff, int wave, int lane, int et, int ev) {
    const int buf = c & 1, l32 = lane & 31, g = lane >> 5;
    if (wave < 4) { const int kt = wave;
        f32x16 acc;
#pragma unroll
        for (int i = 0; i < 16; ++i) acc[i] = 0.f;
#pragma unroll
        for (int kp = 0; kp < 2; ++kp) {
            const bf16x8 qf = *(const LAS bf16x8*)(slot + ((kt * 2 + kp) * 64 + lane) * 16);
            u32x4 sp; sp.x = pk2(S[8 * kp + 0], S[8 * kp + 1]); sp.y = pk2(S[8 * kp + 2], S[8 * kp + 3]); sp.z = pk2(S[8 * kp + 4], S[8 * kp + 5]); sp.w = pk2(S[8 * kp + 6], S[8 * kp + 7]);
            acc = __builtin_amdgcn_mfma_f32_32x32x16_bf16(qf, __builtin_bit_cast(bf16x8, sp), acc, 0, 0, 0); }
        LAS float* opw = OP + ((buf * 4 + kt) * 32) * 32 + l32;
#pragma unroll
        for (int r = 0; r < 16; ++r) opw[((r & 3) + 8 * (r >> 2) + 4 * g) * 32] = acc[r];
        const LAS float* dl = (const LAS float*)(slot + 18432);
#pragma unroll
        for (int j = 0; j < 4; ++j) { const f32x4 dd = *(const LAS f32x4*)(dl + kt * 32 + 4 * g + 8 * j);
            S[4 * j] *= dd[0]; S[4 * j + 1] *= dd[1]; S[4 * j + 2] *= dd[2]; S[4 * j + 3] *= dd[3]; }
#pragma unroll
        for (int kp = 0; kp < 2; ++kp) { const bf16x8 kf = *(const LAS bf16x8*)(slot + ((8 + kt * 2 + kp) * 64 + lane) * 16), vf = *(const LAS bf16x8*)(slot + 16384 + (kp * 64 + lane) * 16);
            S = __builtin_amdgcn_mfma_f32_32x32x16_bf16(kf, vf, S, 0, 0, 0); }
    }
    __syncthreads();
    const LAS float* p = OP + ((buf * 4) * 32 + et) * 32 + ev;
    const f32x2_ a0 = *(const LAS f32x2_*)p, a1 = *(const LAS f32x2_*)(p + 1024), a2 = *(const LAS f32x2_*)(p + 2048), a3 = *(const LAS f32x2_*)(p + 3072);
    *(unsigned*)(INTER + eoff) = pk2((a0[0] + a1[0]) + (a2[0] + a3[0]), (a0[1] + a1[1]) + (a2[1] + a3[1]));
}
__device__ __forceinline__ void p6_chain(const Args& a, LAS unsigned char* lds) {
    const int tid = threadIdx.x, lane = tid & 63, wave = __builtin_amdgcn_readfirstlane(tid >> 6);
    unsigned char* ws = a.ws;
    bf16_t* INTER = (bf16_t*)(ws + WS_QB); const unsigned char* OPI = ws + WS_OPI; const float* DV = (const float*)(ws + WS_DV);
    LAS float* OP = (LAS float*)lds;
    LAS unsigned char* ring = lds + 32768;
    for (int unit = blockIdx.x; unit < 256; unit += gridDim.x) {
        const int vt = (unit >> 3) & 3, q = (unit & 7) + 8 * (unit >> 5), b = q >> 3, h = q & 7, l32 = lane & 31, g = lane >> 5;
        const int et = tid >> 4, ev = (tid & 15) * 2;
        const size_t rbase = (size_t)b * TP; const int item0 = q * 64;
        f32x16 S;
#pragma unroll
        for (int i = 0; i < 16; ++i) S[i] = 0.f;
        __syncthreads();
        Pre6 f0, f1, f2, f3, f4;
#define P6_EOFF(c) ((rbase + (size_t)(c) * 32 + et) * INNER + h * DK + vt * 32 + ev)
#define P6_LOAD(f, c) p6_load(f, OPI, DV, item0 + (c), vt, tid)
#define P6_STAGE(f, c) p6_stage(f, ring + ((c) & 1) * R6_SLOT, tid)
#define P6_STEP(c) p6_step(ring + ((c) & 1) * R6_SLOT, S, OP, INTER, (c), P6_EOFF(c), wave, lane, et, ev)
        P6_LOAD(f0, 0); P6_LOAD(f1, 1); P6_LOAD(f2, 2); P6_LOAD(f3, 3); P6_LOAD(f4, 4);
        P6_STAGE(f0, 0);
        __syncthreads();
        for (int c = 0; c < 60; c += 5) {
            P6_STAGE(f1, c + 1); P6_STEP(c);     if (c + 5 < 64) P6_LOAD(f0, c + 5);
            P6_STAGE(f2, c + 2); P6_STEP(c + 1); if (c + 6 < 64) P6_LOAD(f1, c + 6);
            P6_STAGE(f3, c + 3); P6_STEP(c + 2); if (c + 7 < 64) P6_LOAD(f2, c + 7);
            P6_STAGE(f4, c + 4); P6_STEP(c + 3); if (c + 8 < 64) P6_LOAD(f3, c + 8);
            P6_STAGE(f0, c + 5); P6_STEP(c + 4); if (c + 9 < 64) P6_LOAD(f4, c + 9);
        }
        P6_STAGE(f1, 61); P6_STEP(60);
        P6_STAGE(f2, 62); P6_STEP(61);
        P6_STAGE(f3, 63); P6_STEP(62);
        P6_STEP(63);
#undef P6_EOFF
#undef P6_LOAD
#undef P6_STAGE
#undef P6_STEP
        if (wave < 4) { float* so = a.out + O_SP + (size_t)q * DK * DK;
#pragma unroll
            for (int r = 0; r < 16; ++r) so[(size_t)(wave * 32 + (r & 3) + 8 * (r >> 2) + 4 * g) * DK + vt * 32 + l32] = S[r]; }
    }
}
__device__ __forceinline__ void p6_norm(const Args& a, size_t out_off) {
    const int lane = threadIdx.x & 63, gw = blockIdx.x * NWAVES + (threadIdx.x >> 6), NGW = gridDim.x * NWAVES;
    unsigned char* ws = a.ws;
    const bf16_t* O2 = (const bf16_t*)(ws + WS_QB); bf16_t* O2w = (bf16_t*)(ws + out_off); const bf16_t* INTRA = (const bf16_t*)(a.out + O_Y); const bf16_t* GB = (const bf16_t*)(ws + WS_GB);
    float gn[16];
#pragma unroll
    for (int j = 0; j < 4; ++j) { const f32x4 t4 = *(const f32x4*)(a.in[17] + lane * 16 + 4 * j); gn[4 * j] = t4[0]; gn[4 * j + 1] = t4[1]; gn[4 * j + 2] = t4[2]; gn[4 * j + 3] = t4[3]; }
    for (int m = gw; m < MP; m += NGW) {
        const size_t e = (size_t)m * INNER + lane * 16;
        const u32x4 x0 = *(const u32x4*)(O2 + e), x1 = *(const u32x4*)(O2 + e + 8), y0 = *(const u32x4*)(INTRA + e), y1 = *(const u32x4*)(INTRA + e + 8), g0 = *(const u32x4*)(GB + e), g1 = *(const u32x4*)(GB + e + 8);
        const unsigned xs[8] = {x0.x, x0.y, x0.z, x0.w, x1.x, x1.y, x1.z, x1.w}, ys[8] = {y0.x, y0.y, y0.z, y0.w, y1.x, y1.y, y1.z, y1.w}, gs[8] = {g0.x, g0.y, g0.z, g0.w, g1.x, g1.y, g1.z, g1.w};
        float o[16]; float sq = 0.f;
#pragma unroll
        for (int j = 0; j < 8; ++j) { o[2 * j] = bflo(xs[j]) + bflo(ys[j]); o[2 * j + 1] = bfhi(xs[j]) + bfhi(ys[j]); sq += o[2 * j] * o[2 * j] + o[2 * j + 1] * o[2 * j + 1]; }
        sq += __shfl_xor(sq, 1); sq += __shfl_xor(sq, 2); sq += __shfl_xor(sq, 4);
        const float rstd = __builtin_amdgcn_rsqf(sq * (1.0f / DK) + EPS);
        unsigned w[8];
#pragma unroll
        for (int j = 0; j < 8; ++j) w[j] = pk2(o[2 * j] * rstd * gn[2 * j] * bflo(gs[j]), o[2 * j + 1] * rstd * gn[2 * j + 1] * bfhi(gs[j]));
        *(u32x4*)(O2w + e) = (u32x4){w[0], w[1], w[2], w[3]}; *(u32x4*)(O2w + e + 8) = (u32x4){w[4], w[5], w[6], w[7]};
    }
}
__device__ __forceinline__ void p5b_sample(const Args& a, LAS unsigned char* lds, size_t o2_off) {
    const int tid = threadIdx.x, lane = tid & 63, wave = __builtin_amdgcn_readfirstlane(tid >> 6);
    unsigned char* ws = a.ws;
    const bf16_t* QB = (const bf16_t*)(ws + WS_QB); const bf16_t* VB = (const bf16_t*)(ws + WS_VB); const bf16_t* GB = (const bf16_t*)(ws + WS_GB);
    bf16_t* O2 = (bf16_t*)(ws + o2_off); const float* og = a.in[17];
    {
        const float* LGs = (const float*)(ws + WS_LGS); const float* S0 = a.in[4]; float* S1 = a.out + O_SS;
        LAS float* gq = (LAS float*)lds; LAS float* gg = gq + 512; LAS float* gk = gq + 1024; LAS float* gv = gq + 1536;
        LAS float* ops = gq + 2048;
        LAS float* red = ops + 8192;
        for (int it = blockIdx.x; it < NSQ * NH; it += gridDim.x) {
            const int s = it >> 3, h = it & 7;
            __syncthreads();
            { const int t = tid >> 7, k = tid & 127; const size_t rs = (size_t)(s * 4 + t) * INNER + h * DK + k;
              const float gl = ex2(LGs[rs]); gg[tid] = gl; gk[tid] = 1.0f - gl; gq[tid] = bf2f(QB[(size_t)MP * INNER + rs]); gv[tid] = bf2f(VB[(size_t)MP * INNER + rs]); }
            const int v4 = (tid & 31) * 4, kg = tid >> 5;
            f32x4 St[8]; const size_t sb = ((size_t)it * DK + kg * 8) * DK + v4;
#pragma unroll
            for (int i = 0; i < 8; ++i) St[i] = *(const f32x4*)(S0 + sb + (size_t)i * DK);
            __syncthreads();
#pragma unroll
            for (int t = 0; t < 4; ++t) { const f32x4 vv = *(const LAS f32x4*)(gv + t * 128 + v4); f32x4 op = {0.f, 0.f, 0.f, 0.f};
#pragma unroll
                for (int i = 0; i < 8; ++i) { const int k = t * 128 + kg * 8 + i; const float g_ = gg[k], k_ = gk[k], q_ = gq[k];
                    St[i] = St[i] * g_ + vv * k_; op += St[i] * q_; }
                *(LAS f32x4*)(ops + (kg * 4 + t) * 128 + v4) = op; }
#pragma unroll
            for (int i = 0; i < 8; ++i) *(f32x4*)(S1 + sb + (size_t)i * DK) = St[i];
            __syncthreads();
            { const int t = tid >> 7, v = tid & 127; float o = 0.f;
#pragma unroll
              for (int kq = 0; kq < 16; ++kq) o += ops[(kq * 4 + t) * 128 + v];
              const float sq = wave_sum(o * o);
              if (lane == 0) red[wave] = sq;
              __syncthreads();
              const float rstd = __builtin_amdgcn_rsqf((red[2 * t] + red[2 * t + 1]) * (1.0f / DK) + EPS);
              const size_t rs = (size_t)(MP + s * 4 + t) * INNER + h * DK + v;
              O2[rs] = (bf16_t)f2bf(o * rstd * og[h * DK + v] * bf2f(GB[rs])); }
        }
    }
}
__device__ __forceinline__ void p7_final(const Args& a, float* outp) {
    const int lane = threadIdx.x & 63, gw = blockIdx.x * NWAVES + (threadIdx.x >> 6), NGW = gridDim.x * NWAVES;
    const float* ss2 = (const float*)(a.ws + WS_SS2); const f32x4* fg = (const f32x4*)a.in[19] + lane;
    f32x4 gn[4];
#pragma unroll
    for (int j = 0; j < 4; ++j) gn[j] = fg[64 * j];
    for (int m = gw; m < M; m += NGW) {
        const float rstd = __builtin_amdgcn_rsqf(ss2[m] * (1.f / D) + EPS);
        const f32x4* xr = (const f32x4*)(a.out + (size_t)m * D) + lane; f32x4* xo = (f32x4*)(outp + (size_t)m * D) + lane;
#pragma unroll
        for (int j = 0; j < 4; ++j) xo[64 * j] = xr[64 * j] * rstd * gn[j];
    }
}

#define XB_TMO      128
#define XB_XCNT(j)  (256  + 64 * (j))
#define XB_XSUB(j)  (1280 + 64 * (j))
#define XB_XGEN(j)  (2304 + 64 * (j))
#define XB_TOP      3328
#define XB_TOPGEN   3392
#define XCD_BAR_WORDS 3456
#define XB_SPIN_CAP (1u << 18)

__device__ __forceinline__ unsigned xb_ld(unsigned* p)              { return __hip_atomic_load(p, __ATOMIC_RELAXED, __HIP_MEMORY_SCOPE_AGENT); }
__device__ __forceinline__ unsigned xb_add(unsigned* p, unsigned v) { return __hip_atomic_fetch_add(p, v, __ATOMIC_RELAXED, __HIP_MEMORY_SCOPE_AGENT); }
__device__ __forceinline__ unsigned xb_xcc_id() { return (unsigned)__builtin_amdgcn_s_getreg((3 << 11) | 20) & 0xFu; }
#define XB_SPIN(cond, bar) do { unsigned _sp = 0; while (cond) { __builtin_amdgcn_s_sleep(1); \
    if ((++_sp & 255u) == 0u) { if (xb_ld(&(bar)[XB_TMO])) break; if (_sp > XB_SPIN_CAP) { atomicAdd(&(bar)[XB_TMO], 1u); break; } } } } while (0)

struct XcdBarrier {
    unsigned* bar; unsigned x;
    volatile LAS unsigned* st;
};

__device__ __forceinline__ XcdBarrier xcd_barrier_post(unsigned* bar, volatile LAS unsigned* st) {
    XcdBarrier b; b.bar = bar; b.x = xb_xcc_id(); b.st = st;
    if (threadIdx.x == 0) (void)xb_add(&bar[XB_XCNT(b.x)], 1u);
    return b;
}
__device__ __forceinline__ void xcd_barrier_complete(unsigned* bar, unsigned x, unsigned& nloc, unsigned& nx) {
    const unsigned G = gridDim.x * gridDim.y * gridDim.z;
    unsigned sum, cnt, mine, sp = 0u;
    for (;;) {
        sum = 0u; cnt = 0u; mine = 0u;
#pragma unroll
        for (unsigned j = 0; j < 16; ++j) { const unsigned c = xb_ld(&bar[XB_XCNT(j)]); sum += c; cnt += (c > 0u) ? 1u : 0u; mine = (j == x) ? c : mine; }
        if (sum == G) break;
        __builtin_amdgcn_s_sleep(1);
        if ((++sp & 255u) == 0u) { if (xb_ld(&bar[XB_TMO])) break; if (sp > XB_SPIN_CAP) { atomicAdd(&bar[XB_TMO], 1u); break; } }
    }
    nloc = mine > 0u ? mine : 1u; nx = cnt > 0u ? cnt : 1u;
}

__device__ __forceinline__ void xcd_barrier(const XcdBarrier& b) {
    asm volatile("s_waitcnt vmcnt(0)" ::: "memory");
    __syncthreads();
    if (threadIdx.x == 0) {
        unsigned* bar = b.bar;
        __builtin_amdgcn_s_waitcnt(0);
        unsigned nloc = b.st[0], nx = b.st[1];
        if (nloc == 0u) { xcd_barrier_complete(bar, b.x, nloc, nx); b.st[0] = nloc; b.st[1] = nx; }
        const unsigned old = xb_add(&bar[XB_XSUB(b.x)], 1u);
        const unsigned gen = old / nloc;
        if (old + 1u == (gen + 1u) * nloc) {
            __builtin_amdgcn_fence(__ATOMIC_RELEASE, "agent");
            asm volatile("s_waitcnt vmcnt(0)" ::: "memory");
            const unsigned og = xb_add(&bar[XB_TOP], 1u);
            const unsigned tg = og / nx;
            if (og + 1u == (tg + 1u) * nx) xb_add(&bar[XB_TOPGEN], 1u);
            else XB_SPIN(xb_ld(&bar[XB_TOPGEN]) == tg, bar);
            __builtin_amdgcn_fence(__ATOMIC_ACQUIRE, "agent");
            xb_add(&bar[XB_XGEN(b.x)], 1u);
            asm volatile("s_waitcnt vmcnt(0)" ::: "memory");
        } else {
            XB_SPIN(xb_ld(&bar[XB_XGEN(b.x)]) == gen, bar);
            __builtin_amdgcn_fence(__ATOMIC_ACQUIRE, "agent");
            asm volatile("s_waitcnt vmcnt(0)" ::: "memory");
        }
    }
    __syncthreads();
}

__global__ void __launch_bounds__(NTHREADS, 2) mk_fwd(Args a) {
    extern __shared__ __attribute__((aligned(16))) unsigned char lds_raw[];
    LAS unsigned char* lds = (LAS unsigned char*)lds_raw;
    unsigned char* ws = a.ws; const int G = gridDim.x, lo = a.ph_lo, hi = a.ph_hi;
#define IN(p) (lo <= (p) && (p) < hi)
#if MK_USE_CG
    cg::grid_group grid = cg::this_grid();
#define SEAM(p) do { if (IN(p) && IN((p) + 1)) grid.sync(); } while (0)
#else
    volatile LAS unsigned* misc = (volatile LAS unsigned*)(lds + LDS_BYTES - 64);
    if (threadIdx.x < 16) misc[threadIdx.x] = 0u;
    __syncthreads();
    XcdBarrier bar; bar.bar = (unsigned*)ws; bar.x = 0; bar.st = nullptr;
    if (hi - lo > 1) bar = xcd_barrier_post((unsigned*)ws, misc);
#define SEAM(p) do { if (IN(p) && IN((p) + 1)) xcd_barrier(bar); } while (0)
#endif
    if (IN(0)) { p0_prologue(a, lds); if (MK_DUP == 0) p0_prologue(a, lds); }
    SEAM(0);
    if (IN(1)) { pg8::Gemm g{(const bf16_t*)(ws + WS_XA), (const bf16_t*)(ws + WS_W1T), M, 2 * WL, D}; pg8::StaticOrder S; S.init(M, 2 * WL, G, (int)blockIdx.x);
        Epi1 E{(bf16_t*)(ws + WS_XB), (bf16_t*)(ws + WS_GS), a.out + O_BP, a.out + O_BS};
        pg8::gemm_phase<Epi1, pg8::StaticOrder, true, true>(lds, g, S, E);
        { const int extra = S.nwg % G;
          if ((int)blockIdx.x >= extra) p0_late_weights(a, lds, (int)blockIdx.x - extra, G - extra); } }
    SEAM(1);
    if (IN(2)) { p2_lru(a, lds); if (MK_DUP == 2) p2_lru(a, lds); }
    SEAM(2);
    if (IN(3)) { pg8::Gemm g{(const bf16_t*)(ws + WS_Y), (const bf16_t*)(ws + WS_W2T), MP, D, WL}; pg8::StaticOrder S; S.init(MP, D, G, (int)blockIdx.x);
        Epi2 E{a.in[0], a.in[1], a.out + O_Y, (bf16_t*)(ws + WS_XA), (float*)(ws + WS_SS1)};
        pg8::gemm_phase<Epi2, pg8::StaticOrder, true, true>(lds, g, S, E);
        small_gemm_sample<0>((const bf16_t*)(ws + WS_Y), (const bf16_t*)(ws + WS_W2T), WL, a.in[1], a.out + O_Y, (bf16_t*)(ws + WS_XA), (float*)(ws + WS_SS1)); }
    SEAM(3);
    if (IN(4)) { pg8::Gemm g{(const bf16_t*)(ws + WS_XA), (const bf16_t*)(ws + WS_W3T), M, 4 * INNER, D}; pg8::StaticOrder S; S.init(M, 4 * INNER, G, (int)blockIdx.x);
        Epi3 E{(const float*)(ws + WS_SS1), a.in[16], (bf16_t*)(ws + WS_QB), (bf16_t*)(ws + WS_VB), (bf16_t*)(ws + WS_GB), a.out + O_SS, (float*)(ws + WS_LGS)};
        pg8::gemm_phase<Epi3, pg8::StaticOrder, true, true>(lds, g, S, E); if (MK_DUP == 4) pg8::gemm_phase<Epi3, pg8::StaticOrder, true, true>(lds, g, S, E); }
    SEAM(4);
    if (IN(5)) { p5a_prep(a, lds); if (MK_DUP == 5) p5a_prep(a, lds); if (hi - lo > 1) xcd_barrier(bar); p5b_sample(a, lds, WS_QB); }
    SEAM(5);
    if (IN(6)) { p6_chain(a, lds); if (MK_DUP == 6) p6_chain(a, lds); if (hi - lo > 1) xcd_barrier(bar); if (MK_DUP == 11) p6_norm(a, WS_VB); p6_norm(a, WS_QB); }
    SEAM(6);
    if (IN(7)) { pg8::Gemm g{(const bf16_t*)(ws + WS_QB), (const bf16_t*)(ws + WS_W4T), MP, D, INNER}; pg8::StaticOrder S; S.init(MP, D, G, (int)blockIdx.x);
        Epi4 E{(const bf16_t*)(ws + WS_XA), (float*)(ws + WS_SS2), a.out + O_Y};
        pg8::gemm_phase<Epi4, pg8::StaticOrder, true, true>(lds, g, S, E);
        small_gemm_sample<1>((const bf16_t*)(ws + WS_QB), (const bf16_t*)(ws + WS_W4T), INNER, nullptr, a.out + O_Y, (const bf16_t*)(ws + WS_XA), (float*)(ws + WS_SS2)); }
    SEAM(7);
    if (MK_DUP == 9 && hi - lo > 1) { xcd_barrier(bar); xcd_barrier(bar); xcd_barrier(bar); xcd_barrier(bar); }
    if (IN(8)) { if (MK_DUP == 8) p7_final(a, (float*)(ws + WS_VB)); p7_final(a, a.out); }
#undef IN
#undef SEAM
}

extern "C" void kernel_launch(void* const* d_in, const int* in_sizes, int n_in, void* d_out, int out_size, void* d_ws, size_t ws_size, hipStream_t stream) {
    static int grid = 0;
    if (grid == 0) {
        int dev = 0, cus = 0, per_cu = 0;
        if (n_in != 20 || out_size != 35962880 || ws_size < WS_END) { fprintf(stderr, "kernel_launch: unexpected shapes (n_in %d out %d ws %zu)\n", n_in, out_size, ws_size); grid = -1; return; }
        hipGetDevice(&dev); hipDeviceGetAttribute(&cus, hipDeviceAttributeMultiprocessorCount, dev);
        if (hipFuncSetAttribute((const void*)mk_fwd, hipFuncAttributeMaxDynamicSharedMemorySize, LDS_BYTES) != hipSuccess) { fprintf(stderr, "kernel_launch: hipFuncSetAttribute failed\n"); grid = -1; return; }
        if (hipOccupancyMaxActiveBlocksPerMultiprocessor(&per_cu, (const void*)mk_fwd, NTHREADS, LDS_BYTES) != hipSuccess || per_cu < 1) { fprintf(stderr, "kernel_launch: occupancy query says %d\n", per_cu); grid = -1; (void)hipGetLastError(); return; }
        grid = cus;
        if (grid < 128) { fprintf(stderr, "kernel_launch: only %d CUs\n", grid); grid = -1; return; }
    }
    if (grid < 0) return;
    Args a{};
    for (int i = 0; i < 20; ++i) a.in[i] = (const float*)d_in[i];
    a.out = (float*)d_out; a.ws = (unsigned char*)d_ws;
#if MK_LAUNCHES == 1
    a.ph_lo = 0; a.ph_hi = NPHASE;
#if !MK_USE_CG
    if (hipMemsetAsync(d_ws, 0, 65536, stream) != hipSuccess) { fprintf(stderr, "kernel_launch: memset of the barrier words failed\n"); return; }
#endif
    void* args[] = {&a};
    hipError_t e = hipLaunchCooperativeKernel((const void*)mk_fwd, dim3(grid), dim3(NTHREADS), args, LDS_BYTES, stream);
    if (e != hipSuccess) fprintf(stderr, "cooperative launch failed: %s (grid %d)\n", hipGetErrorString(e), grid);
#else
    for (int p = 0; p < NPHASE; ++p) { a.ph_lo = p; a.ph_hi = p + 1;
        hipLaunchKernelGGL(mk_fwd, dim3(grid), dim3(NTHREADS), LDS_BYTES, stream, a); }
#endif
}
```
